# Optimizing an MI355X kernel written in HIP

```python
import jax, jax.numpy as jnp
from jax import lax
import numpy as np

D_MODEL = 1024
BATCH = 4
SEQ = 8192
DEPTH = 1

PLE_DIM = 256
MIX_WIDTH = D_MODEL
MLA_WIDTH = MIX_WIDTH // 2
CONV_WIDTH = MIX_WIDTH - MLA_WIDTH
N_HEADS = 8
V_HEAD_DIM = MLA_WIDTH // N_HEADS
QK_NOPE_DIM = 64
QK_ROPE_DIM = 32
Q_LORA = 3 * D_MODEL // 8
KV_LORA = D_MODEL // 4
CONV_K = 3
CONV_GROUPS = 8
N_GROUPS = 4
EXPERTS_PER_GROUP = 8
N_EXPERTS = N_GROUPS * EXPERTS_PER_GROUP
TOP_K = 2
EXPERT_FF = D_MODEL // 2
ROPE_BASE = 10000.0
EPS = 1e-6
Q_BLOCK = 128
MOE_BLOCK = 128
IN_SPLITS = (Q_LORA, KV_LORA, QK_ROPE_DIM, CONV_WIDTH, CONV_WIDTH, CONV_WIDTH)
IN_COLS = sum(IN_SPLITS)

kernel_name = "hybrid_mla_shortconv_hmoe_ple"


def rmsnorm(x, g):
    xf = x.astype(jnp.float32)
    y = xf * lax.rsqrt(jnp.mean(xf * xf, axis=-1, keepdims=True) + EPS)
    return (y * g.astype(jnp.float32)).astype(x.dtype)


def rope_tables(positions):
    inv_freq = ROPE_BASE ** (-jnp.arange(0, QK_ROPE_DIM, 2, dtype=jnp.float32) / QK_ROPE_DIM)
    ang = positions.astype(jnp.float32)[..., None] * inv_freq
    return jnp.cos(ang)[:, :, None, :], jnp.sin(ang)[:, :, None, :]


def apply_rope(x, cos, sin):
    half = QK_ROPE_DIM // 2
    x1, x2 = x[..., :half], x[..., half:]
    c, s = cos.astype(x.dtype), sin.astype(x.dtype)
    return jnp.concatenate([x1 * c - x2 * s, x2 * c + x1 * s], axis=-1)


def mla_mixer(c_q, c_kv, k_rope_raw, q_norm_g, w_uq, kv_norm_g, w_ukv, cos, sin):
    B, S, _ = c_q.shape
    q = jnp.einsum('bsr,rhd->bshd', rmsnorm(c_q, q_norm_g), w_uq)
    q_nope = q[..., :QK_NOPE_DIM]
    q_rope = apply_rope(q[..., QK_NOPE_DIM:], cos, sin)
    kv = jnp.einsum('bsr,rhd->bshd', rmsnorm(c_kv, kv_norm_g), w_ukv)
    k_nope, v = kv[..., :QK_NOPE_DIM], kv[..., QK_NOPE_DIM:]
    k_rope = apply_rope(k_rope_raw[:, :, None, :], cos, sin)[:, :, 0, :]
    scale = (QK_NOPE_DIM + QK_ROPE_DIM) ** -0.5
    outs = []
    for i in range(S // Q_BLOCK):
        q0, q1 = i * Q_BLOCK, (i + 1) * Q_BLOCK
        s = (jnp.einsum('bqhd,bkhd->bhqk', q_nope[:, q0:q1], k_nope[:, :q1])
             + jnp.einsum('bqhr,bkr->bhqk', q_rope[:, q0:q1], k_rope[:, :q1]))
        s = s.astype(jnp.float32) * scale
        mask = jnp.arange(q0, q1)[:, None] >= jnp.arange(q1)[None, :]
        s = jnp.where(mask, s, -jnp.inf)
        pr = jax.nn.softmax(s, axis=-1).astype(v.dtype)
        outs.append(jnp.einsum('bhqk,bkhd->bqhd', pr, v[:, :q1]))
    o = jnp.concatenate(outs, axis=1)
    return o.reshape(B, S, MLA_WIDTH)


def short_conv_mixer(b_gate, c_gate, u, conv_w):
    cu = c_gate * u
    y = lax.conv_general_dilated(cu, conv_w.astype(cu.dtype), window_strides=(1,),
                                 padding=((CONV_K - 1, 0),),
                                 dimension_numbers=('NWC', 'WIO', 'NWC'),
                                 feature_group_count=CONV_WIDTH)
    return b_gate * y


def hier_moe(xn, w_group_router, b_group_router, w_expert_router, b_expert_router,
             w_gate, w_up, w_down):
    B, S, D = xn.shape
    N = B * S
    xt = xn.reshape(N, D)
    xf = xt.astype(jnp.float32)
    g_prob = jax.nn.softmax(xf @ w_group_router.astype(jnp.float32)
                            + b_group_router.astype(jnp.float32), axis=-1)
    g_p, g_idx = lax.top_k(g_prob, 1)
    e_logits = (xf @ w_expert_router.astype(jnp.float32)
                + b_expert_router.astype(jnp.float32)).reshape(N, N_GROUPS, EXPERTS_PER_GROUP)
    e_logits = jnp.take_along_axis(e_logits, g_idx[:, :, None], axis=1)[:, 0]
    e_p, e_i = lax.top_k(jax.nn.softmax(e_logits, axis=-1), TOP_K)
    weights = g_p * (e_p / jnp.sum(e_p, axis=-1, keepdims=True))
    expert_ids = g_idx * EXPERTS_PER_GROUP + e_i

    A = N * TOP_K
    flat_e = expert_ids.reshape(A).astype(jnp.int32)
    flat_tok = jnp.repeat(jnp.arange(N, dtype=jnp.int32), TOP_K)
    flat_w = weights.reshape(A)
    order = jnp.argsort(flat_e, stable=True)
    se, stok, sw = flat_e[order], flat_tok[order], flat_w[order]
    counts = jnp.zeros((N_EXPERTS,), jnp.int32).at[flat_e].add(1)
    starts = jnp.cumsum(counts) - counts
    padded = (counts + MOE_BLOCK - 1) // MOE_BLOCK * MOE_BLOCK
    pad_ends = jnp.cumsum(padded)
    pad_starts = pad_ends - padded
    dest = pad_starts[se] + jnp.arange(A, dtype=jnp.int32) - starts[se]
    n_blocks = A // MOE_BLOCK + N_EXPERTS
    P = n_blocks * MOE_BLOCK
    row_tok = jnp.full((P,), N, jnp.int32).at[dest].set(stok)
    row_w = jnp.zeros((P,), jnp.float32).at[dest].set(sw)
    blk_e = jnp.minimum(jnp.searchsorted(pad_ends, jnp.arange(n_blocks, dtype=jnp.int32) * MOE_BLOCK,
                                         side='right'), N_EXPERTS - 1).astype(jnp.int32)
    x_pad = jnp.concatenate([xt, jnp.zeros((1, D), xt.dtype)], axis=0)
    xb = x_pad[row_tok].reshape(n_blocks, MOE_BLOCK, D)

    def expert_block(args):
        xblk, e = args
        hdn = jax.nn.silu(xblk @ w_gate[e]) * (xblk @ w_up[e])
        return hdn @ w_down[e]

    yb = lax.map(expert_block, (xb, blk_e)).reshape(P, D)
    y = jnp.zeros((N + 1, D), yb.dtype).at[row_tok].add(yb * row_w[:, None].astype(yb.dtype))
    return y[:N].reshape(B, S, D)


def setup_inputs(seed: int = 0) -> dict:
    key = jax.random.key(seed)
    ks = jax.random.split(key, 24)
    f32 = jnp.float32

    def nrm(k, shape, scale):
        return jax.random.normal(k, shape, f32) * scale

    def gain(k, shape):
        return 1.0 + 0.01 * jax.random.normal(k, shape, f32)

    x = jax.random.normal(ks[0], (BATCH, SEQ, D_MODEL), f32)
    p = jax.random.normal(ks[1], (DEPTH, BATCH, SEQ, PLE_DIM), f32)
    offs = jax.random.randint(ks[2], (BATCH, 1), 0, 1024, dtype=jnp.int32)
    positions = offs + jnp.arange(SEQ, dtype=jnp.int32)[None, :]
    return {
        "x": x,
        "p": p,
        "positions": positions,
        "attn_norm_g": gain(ks[3], (DEPTH, D_MODEL)),
        "w_in": nrm(ks[4], (DEPTH, D_MODEL, IN_COLS), D_MODEL ** -0.5),
        "q_norm_g": gain(ks[5], (DEPTH, Q_LORA)),
        "w_uq": nrm(ks[6], (DEPTH, Q_LORA, N_HEADS, QK_NOPE_DIM + QK_ROPE_DIM), Q_LORA ** -0.5),
        "kv_norm_g": gain(ks[7], (DEPTH, KV_LORA)),
        "w_ukv": nrm(ks[8], (DEPTH, KV_LORA, N_HEADS, QK_NOPE_DIM + V_HEAD_DIM), KV_LORA ** -0.5),
        "conv_w": nrm(ks[9], (DEPTH, CONV_K, 1, CONV_WIDTH), CONV_K ** -0.5),
        "w_out": nrm(ks[10], (DEPTH, MIX_WIDTH, D_MODEL), MIX_WIDTH ** -0.5),
        "moe_norm_g": gain(ks[11], (DEPTH, D_MODEL)),
        "w_group_router": nrm(ks[12], (DEPTH, D_MODEL, N_GROUPS), D_MODEL ** -0.5),
        "b_group_router": nrm(ks[13], (DEPTH, N_GROUPS), 0.01),
        "w_expert_router": nrm(ks[14], (DEPTH, D_MODEL, N_EXPERTS), D_MODEL ** -0.5),
        "b_expert_router": nrm(ks[15], (DEPTH, N_EXPERTS), 0.01),
        "w_gate": nrm(ks[16], (DEPTH, N_EXPERTS, D_MODEL, EXPERT_FF), D_MODEL ** -0.5),
        "w_up": nrm(ks[17], (DEPTH, N_EXPERTS, D_MODEL, EXPERT_FF), D_MODEL ** -0.5),
        "w_down": nrm(ks[18], (DEPTH, N_EXPERTS, EXPERT_FF, D_MODEL), EXPERT_FF ** -0.5),
        "ple_norm_g": gain(ks[19], (DEPTH, D_MODEL)),
        "w_ple_gate": nrm(ks[20], (DEPTH, D_MODEL, D_MODEL), D_MODEL ** -0.5),
        "b_ple_gate": nrm(ks[21], (DEPTH, D_MODEL), 0.01),
        "w_ple_proj": nrm(ks[22], (DEPTH, PLE_DIM, D_MODEL), PLE_DIM ** -0.5),
        "final_norm_g": gain(ks[23], (D_MODEL,)),
    }


def reference(x, p, positions, attn_norm_g, w_in, q_norm_g, w_uq, kv_norm_g, w_ukv, conv_w,
              w_out, moe_norm_g, w_group_router, b_group_router, w_expert_router,
              b_expert_router, w_gate, w_up, w_down, ple_norm_g, w_ple_gate, b_ple_gate,
              w_ple_proj, final_norm_g):
    cos, sin = rope_tables(positions)
    split_pts = [int(v) for v in np.cumsum(IN_SPLITS)[:-1]]
    h = x
    for i in range(DEPTH):
        xn = rmsnorm(h, attn_norm_g[i])
        z = xn @ w_in[i]
        c_q, c_kv, k_r, b_g, c_g, u = jnp.split(z, split_pts, axis=-1)
        o_mla = mla_mixer(c_q, c_kv, k_r, q_norm_g[i], w_uq[i], kv_norm_g[i], w_ukv[i], cos, sin)
        o_conv = short_conv_mixer(b_g, c_g, u, conv_w[i])
        h = h + jnp.concatenate([o_mla, o_conv], axis=-1) @ w_out[i]
        h = h + hier_moe(rmsnorm(h, moe_norm_g[i]), w_group_router[i], b_group_router[i],
                         w_expert_router[i], b_expert_router[i], w_gate[i], w_up[i], w_down[i])
        gate = jax.nn.sigmoid(rmsnorm(h, ple_norm_g[i]) @ w_ple_gate[i] + b_ple_gate[i])
        h = h + gate * (p[i] @ w_ple_proj[i])
    return rmsnorm(h, final_norm_g)
```

```cpp
#include <hip/hip_runtime.h>
#include <cstdio>
#include <cstdint>

#define GAS __attribute__((address_space(1)))
#define LAS __attribute__((address_space(3)))
typedef unsigned short bf16;
typedef unsigned u32x4 __attribute__((ext_vector_type(4)));
typedef unsigned u32x2 __attribute__((ext_vector_type(2)));
typedef float f32x4 __attribute__((ext_vector_type(4)));
typedef float f32x2 __attribute__((ext_vector_type(2)));

constexpr int BATCH = 4, SEQ = 8192, NTOK = BATCH * SEQ, D = 1024, PLE = 256;
constexpr int NH = 8, DQK = 96, DV = 64, QLORA = 384, KVLORA = 256, ROPE_D = 32, CONVW = 512;
constexpr int ZN = 2208, ZC = 2304;
constexpr int CQ0 = 0, CKV0 = 384, KR0 = 640, BG0 = 672, CG0 = 1184, U0 = 1696;
constexpr int NEXP = 32, EPG = 8, NGRP = 4, FF = 512;
constexpr int LISTCAP = 32768;
constexpr int MAXRT = 320;
constexpr float EPS = 1e-6f;
constexpr float QSCALE = 0.14724444602590306f;
constexpr int NTHREADS = 512, NWAVES = 8;

constexpr size_t MiB = 1u << 20;
constexpr size_t WS_CTL = 0, CTL_ZERO_BYTES = 1 * MiB;
constexpr size_t WS_WIN = 1 * MiB;
constexpr size_t WS_WUQ = 6 * MiB;
constexpr size_t WS_WUKV = 7 * MiB;
constexpr size_t WS_WOUT = 8 * MiB;
constexpr size_t WS_WPG = 10 * MiB;
constexpr size_t WS_WPP = 12 * MiB;
constexpr size_t WS_RWT = 13 * MiB;
constexpr size_t WS_ROPE = 14 * MiB;
constexpr size_t WS_SSQ = 18 * MiB;
constexpr size_t WS_LIST = 22 * MiB;
constexpr size_t WS_AW = 26 * MiB;
constexpr size_t WS_WGU = 28 * MiB;
constexpr size_t WS_WD = 92 * MiB;
constexpr size_t WS_PB = 124 * MiB;
constexpr size_t WS_A = 140 * MiB;
constexpr size_t WS_B = 204 * MiB;
constexpr size_t WS_C = 348 * MiB;
constexpr size_t WS_END = 476 * MiB;
constexpr size_t OFF_K = 48 * MiB, OFF_V = 96 * MiB, OFF_PROJ = 80 * MiB;

constexpr int CW_BAR = 4096;
constexpr int CW_CNT = 49152;

constexpr int LDS_BYTES = 147456;
constexpr int LDS_MISC = 131072;

__device__ __forceinline__ unsigned f2bf(float f) { unsigned u = __builtin_bit_cast(unsigned, f); return (u + 0x7fffu + ((u >> 16) & 1u)) >> 16; }
__device__ __forceinline__ unsigned pk2(float lo, float hi) { return f2bf(lo) | (f2bf(hi) << 16); }
__device__ __forceinline__ float bflo(unsigned w) { return __builtin_bit_cast(float, w << 16); }
__device__ __forceinline__ float bfhi(unsigned w) { return __builtin_bit_cast(float, w & 0xffff0000u); }
__device__ __forceinline__ float bf2f(bf16 b) { return __builtin_bit_cast(float, (unsigned)b << 16); }
__device__ __forceinline__ void unpack8(const u32x4 w, float (&v)[8]) {
    v[0] = bflo(w.x); v[1] = bfhi(w.x); v[2] = bflo(w.y); v[3] = bfhi(w.y); v[4] = bflo(w.z); v[5] = bfhi(w.z); v[6] = bflo(w.w); v[7] = bfhi(w.w); }
__device__ __forceinline__ u32x4 pack8(const float (&v)[8]) { u32x4 w; w.x = pk2(v[0], v[1]); w.y = pk2(v[2], v[3]); w.z = pk2(v[4], v[5]); w.w = pk2(v[6], v[7]); return w; }
__device__ __forceinline__ float wave_sum(float v) {
#pragma unroll
    for (int o = 1; o < 64; o <<= 1) v += __shfl_xor(v, o);
    return v;
}

#define XB_TMO      128
#define XB_XCNT(j)  (256  + 64 * (j))
#define XB_XSUB(j)  (1280 + 64 * (j))
#define XB_XGEN(j)  (2304 + 64 * (j))
#define XB_TOP      3328
#define XB_TOPGEN   3392
#define XCD_BAR_WORDS 3456
#define XB_SPIN_CAP (1u << 23)
__device__ __forceinline__ unsigned xb_ld(unsigned* p)              { return __hip_atomic_load(p, __ATOMIC_RELAXED, __HIP_MEMORY_SCOPE_AGENT); }
__device__ __forceinline__ unsigned xb_add(unsigned* p, unsigned v) { return __hip_atomic_fetch_add(p, v, __ATOMIC_RELAXED, __HIP_MEMORY_SCOPE_AGENT); }
__device__ __forceinline__ unsigned xb_xcc_id() { return (unsigned)__builtin_amdgcn_s_getreg((3 << 11) | 20) & 0xFu; }
#define XB_SPIN(cond, bar) do { unsigned _sp = 0; while (cond) { __builtin_amdgcn_s_sleep(1); \
    if ((++_sp & 255u) == 0u) { if (xb_ld(&(bar)[XB_TMO])) break; if (_sp > XB_SPIN_CAP) { atomicAdd(&(bar)[XB_TMO], 1u); break; } } } } while (0)
struct XcdBarrier { unsigned* bar; unsigned x; volatile LAS unsigned* st; };
__device__ __forceinline__ XcdBarrier xcd_barrier_post(unsigned* bar, volatile LAS unsigned* st) {
    XcdBarrier b; b.bar = bar; b.x = xb_xcc_id(); b.st = st;
    if (threadIdx.x == 0) (void)xb_add(&bar[XB_XCNT(b.x)], 1u);
    return b;
}
__device__ __forceinline__ void xcd_barrier_complete(unsigned* bar, unsigned x, unsigned& nloc, unsigned& nx) {
    const unsigned G = gridDim.x * gridDim.y * gridDim.z;
    unsigned sum, cnt, mine, sp = 0u;
    for (;;) {
        sum = 0u; cnt = 0u; mine = 0u;
#pragma unroll
        for (unsigned j = 0; j < 16; ++j) { const unsigned c = xb_ld(&bar[XB_XCNT(j)]); sum += c; cnt += (c > 0u) ? 1u : 0u; mine = (j == x) ? c : mine; }
        if (sum == G) break;
        __builtin_amdgcn_s_sleep(1);
        if ((++sp & 255u) == 0u) { if (xb_ld(&bar[XB_TMO])) break; if (sp > XB_SPIN_CAP) { atomicAdd(&bar[XB_TMO], 1u); break; } }
    }
    nloc = mine > 0u ? mine : 1u; nx = cnt > 0u ? cnt : 1u;
}
__device__ __forceinline__ void xcd_barrier(const XcdBarrier& b) {
    asm volatile("s_waitcnt vmcnt(0)" ::: "memory");
    __syncthreads();
    if (threadIdx.x == 0) {
        unsigned* bar = b.bar;
        __builtin_amdgcn_s_waitcnt(0);
        unsigned nloc = b.st[0], nx = b.st[1];
        if (nloc == 0u) { xcd_barrier_complete(bar, b.x, nloc, nx); b.st[0] = nloc; b.st[1] = nx; }
        const unsigned old = xb_add(&bar[XB_XSUB(b.x)], 1u);
        const unsigned gen = old / nloc;
        if (old + 1u == (gen + 1u) * nloc) {
            __builtin_amdgcn_fence(__ATOMIC_RELEASE, "agent");
            asm volatile("s_waitcnt vmcnt(0)" ::: "memory");
            const unsigned og = xb_add(&bar[XB_TOP], 1u);
            const unsigned tg = og / nx;
            if (og + 1u == (tg + 1u) * nx) xb_add(&bar[XB_TOPGEN], 1u);
            else XB_SPIN(xb_ld(&bar[XB_TOPGEN]) == tg, bar);
            __builtin_amdgcn_fence(__ATOMIC_ACQUIRE, "agent");
            xb_add(&bar[XB_XGEN(b.x)], 1u);
            asm volatile("s_waitcnt vmcnt(0)" ::: "memory");
        } else {
            XB_SPIN(xb_ld(&bar[XB_XGEN(b.x)]) == gen, bar);
            __builtin_amdgcn_fence(__ATOMIC_ACQUIRE, "agent");
            asm volatile("s_waitcnt vmcnt(0)" ::: "memory");
        }
    }
    __syncthreads();
}

struct Args { const void* in[24]; float* out; unsigned char* ws; int ph_lo, ph_hi; };
struct Frame {
    char* lds;
    int tid, lane, wave, G, bid;
    unsigned* ctl;
    const float *x, *p; const int* pos;
    const float *attn_g, *w_in, *q_g, *w_uq, *kv_g, *w_ukv, *conv_w, *w_out, *moe_g, *w_gr, *b_gr, *w_er, *b_er, *w_gate, *w_up, *w_down, *ple_g, *w_pg, *b_pg, *w_pp, *fin_g;
    float* out;
    bf16 *WinT, *WuqT, *WukvT, *WoutT, *WpgT, *WppT, *WguT, *WdT, *PB, *RA, *Z, *HBUF, *PROJ, *Q, *K, *V, *YBUF;
    float *RWT, *ROPE, *SSQ, *AW; int* LIST;
};

__device__ const double INVF[16] = {1.0, 0.5623413251903491, 0.31622776601683794, 0.1778279410038923, 0.1, 0.05623413251903491, 0.03162277660168379, 0.01778279410038923,
                                    0.01, 0.005623413251903491, 0.0031622776601683794, 0.0017782794100389228, 0.001, 0.0005623413251903491, 0.00031622776601683794, 0.00017782794100389227};

__device__ __forceinline__ void wt_item(const float* W, int ldw, const float* ksc, bf16* WT, int K, int k0, int n0, int srccol, float* scr, int lane) {
#pragma unroll 8
    for (int i = 0; i < 32; ++i) { const int kk = 2 * i + (lane >> 5);
        float v = 0.f; if (srccol >= 0) { v = W[(size_t)(k0 + kk) * ldw + srccol]; if (ksc) v *= ksc[k0 + kk]; }
        scr[kk * 33 + (lane & 31)] = v; }
    __builtin_amdgcn_s_waitcnt(0); asm volatile("" ::: "memory");
    const int c = lane & 7;
#pragma unroll
    for (int j = 0; j < 4; ++j) { const int n = (lane >> 3) + 8 * j; const float* s = scr + (8 * c) * 33 + n;
        u32x4 o; o.x = pk2(s[0 * 33], s[1 * 33]); o.y = pk2(s[2 * 33], s[3 * 33]); o.z = pk2(s[4 * 33], s[5 * 33]); o.w = pk2(s[6 * 33], s[7 * 33]);
        *(u32x4*)(WT + (size_t)(n0 + n) * K + k0 + 8 * c) = o; }
    __builtin_amdgcn_s_waitcnt(0); asm volatile("" ::: "memory");
}
__device__ __forceinline__ int uq_srccol(int n) {
    const int h = n / 96, p = n % 96; if (p < 64) return h * 96 + p;
    const int r = p - 64, g = r >> 3, j = r & 7, i = 4 * g + (j & 3); return h * 96 + 64 + ((j < 4) ? i : 16 + i);
}
__device__ __forceinline__ void rms_row_to_bf16(const float* xrow, const float* g, bf16* orow, int lane) {
    const f32x4* xr = (const f32x4*)xrow + lane; const f32x4* gr = (const f32x4*)g + lane;
    f32x4 v[4]; float s = 0.f;
#pragma unroll
    for (int j = 0; j < 4; ++j) { v[j] = xr[64 * j]; s += (v[j].x * v[j].x + v[j].y * v[j].y) + (v[j].z * v[j].z + v[j].w * v[j].w); }
    const float rinv = 1.f / sqrtf(wave_sum(s) * (1.f / D) + EPS);
    u32x2* o8 = (u32x2*)orow + lane;
#pragma unroll
    for (int j = 0; j < 4; ++j) { const f32x4 gg = gr[64 * j]; u32x2 o; o.x = pk2(v[j].x * rinv * gg.x, v[j].y * rinv * gg.y); o.y = pk2(v[j].z * rinv * gg.z, v[j].w * rinv * gg.w); o8[64 * j] = o; }
}
__device__ __forceinline__ void p0_prologue(Frame& F) {
    float* scr = (float*)(F.lds + F.wave * 16384);
    const int gw = F.bid * NWAVES + F.wave, NGW = F.G * NWAVES, lane = F.lane;
    constexpr int I_IN = (ZC / 32) * (D / 64), I_UQ = (768 / 32) * (QLORA / 64), I_UKV = (1024 / 32) * (KVLORA / 64), I_OUT = 32 * 16, I_PG = 32 * 16, I_PP = 32 * 4;
    constexpr int I_GU1 = 32 * 16, I_GU = NEXP * I_GU1, I_D1 = 32 * 8, I_DD = NEXP * I_D1;
    constexpr int NITEMS = I_IN + I_UQ + I_UKV + I_OUT + I_PG + I_PP + I_GU + I_DD;
    for (int it = gw; it < NITEMS; it += NGW) {
        int r = it;
        if (r < I_IN) { const int nb = r / 16, kb = r % 16, n = nb * 32 + (lane & 31); wt_item(F.w_in, ZN, nullptr, F.WinT, D, kb * 64, nb * 32, n < ZN ? n : -1, scr, lane); continue; } r -= I_IN;
        if (r < I_UQ) { const int nb = r / 6, kb = r % 6, n = nb * 32 + (lane & 31); wt_item(F.w_uq, 768, F.q_g, F.WuqT, QLORA, kb * 64, nb * 32, uq_srccol(n), scr, lane); continue; } r -= I_UQ;
        if (r < I_UKV) { const int nb = r / 4, kb = r % 4, n = nb * 32 + (lane & 31); wt_item(F.w_ukv, 1024, F.kv_g, F.WukvT, KVLORA, kb * 64, nb * 32, n, scr, lane); continue; } r -= I_UKV;
        if (r < I_OUT) { const int nb = r / 16, kb = r % 16, n = nb * 32 + (lane & 31); wt_item(F.w_out, D, nullptr, F.WoutT, D, kb * 64, nb * 32, n, scr, lane); continue; } r -= I_OUT;
        if (r < I_PG) { const int nb = r / 16, kb = r % 16, n = nb * 32 + (lane & 31); wt_item(F.w_pg, D, nullptr, F.WpgT, D, kb * 64, nb * 32, n, scr, lane); continue; } r -= I_PG;
        if (r < I_PP) { const int nb = r / 4, kb = r % 4, n = nb * 32 + (lane & 31); wt_item(F.w_pp, D, nullptr, F.WppT, PLE, kb * 64, nb * 32, n, scr, lane); continue; } r -= I_PP;
        if (r < I_GU) { const int e = r / I_GU1, q = r % I_GU1, nb = q / 16, kb = q % 16, n = nb * 32 + (lane & 31), t = n >> 8, w = n & 255;
            const float* W = ((w < 128) ? F.w_gate : F.w_up) + (size_t)e * D * FF;
            wt_item(W, FF, nullptr, F.WguT + (size_t)e * 1024 * 1024, D, kb * 64, nb * 32, 128 * t + (w & 127), scr, lane); continue; } r -= I_GU;
        { const int e = r / I_D1, q = r % I_D1, nb = q / 8, kb = q % 8, n = nb * 32 + (lane & 31);
            wt_item(F.w_down + (size_t)e * FF * D, D, nullptr, F.WdT + (size_t)e * 1024 * 512, FF, kb * 64, nb * 32, n, scr, lane); }
    }
    for (int m = gw; m < NTOK; m += NGW) rms_row_to_bf16(F.x + (size_t)m * D, F.attn_g, F.RA + (size_t)m * D, lane);
    { const int gt = F.bid * NTHREADS + F.tid, NGT = F.G * NTHREADS;
      for (int i = gt; i < NTOK * PLE / 8; i += NGT) { const f32x4 a = ((const f32x4*)F.p)[2 * i], b = ((const f32x4*)F.p)[2 * i + 1];
          u32x4 o; o.x = pk2(a.x, a.y); o.y = pk2(a.z, a.w); o.z = pk2(b.x, b.y); o.w = pk2(b.z, b.w); ((u32x4*)F.PB)[i] = o; }
      for (int i = gt; i < NTOK * 16; i += NGT) { const int m = i >> 4, f = i & 15;
          const float ang = (float)F.pos[m] * (float)INVF[f];
          double t = (double)ang * 0.15915494309189535; t -= __builtin_floor(t); if (t >= 0.5) t -= 1.0;
          const double xx = t * 6.283185307179586, x2 = xx * xx;
          double c = 1.0 / 620448401733239439360000.0, s = 1.0 / 15511210043330985984000000.0;
          c = c * -x2 + 1.0 / 1124000727777607680000.0;  s = s * -x2 + 1.0 / 25852016738884976640000.0;
          c = c * -x2 + 1.0 / 2432902008176640000.0;     s = s * -x2 + 1.0 / 51090942171709440000.0;
          c = c * -x2 + 1.0 / 6402373705728000.0;        s = s * -x2 + 1.0 / 121645100408832000.0;
          c = c * -x2 + 1.0 / 20922789888000.0;          s = s * -x2 + 1.0 / 355687428096000.0;
          c = c * -x2 + 1.0 / 87178291200.0;             s = s * -x2 + 1.0 / 1307674368000.0;
          c = c * -x2 + 1.0 / 479001600.0;               s = s * -x2 + 1.0 / 6227020800.0;
          c = c * -x2 + 1.0 / 3628800.0;                 s = s * -x2 + 1.0 / 39916800.0;
          c = c * -x2 + 1.0 / 40320.0;                   s = s * -x2 + 1.0 / 362880.0;
          c = c * -x2 + 1.0 / 720.0;                     s = s * -x2 + 1.0 / 5040.0;
          c = c * -x2 + 1.0 / 24.0;                      s = s * -x2 + 1.0 / 120.0;
          c = c * -x2 + 0.5;                             s = s * -x2 + 1.0 / 6.0;
          c = c * -x2 + 1.0;                             s = s * -x2 + 1.0;  s *= xx;
          F.ROPE[m * 32 + f] = (float)c; F.ROPE[m * 32 + 16 + f] = (float)s; }
      for (int i = gt; i < 36 * D; i += NGT) { const int j = i / D, k = i % D; F.RWT[i] = (j < 4) ? F.w_gr[k * 4 + j] : F.w_er[k * 32 + (j - 4)]; }
    }
}

template <bool DUAL, class Epi>
__device__ __forceinline__ void ngemm_tile(char* lds, const bf16* A, int lda, const int* gath, int gcount, const bf16* B, const bf16* B2, int ldb, int K, const Epi& epi) {
    float* As = (float*)lds; float* Bs = As + 32 * 132; float* Bs2 = Bs + 32 * 68;
    const int t = threadIdx.x, ty = t >> 3, tx = t & 7, lr = t >> 2, lc = (t & 3) * 8;
    float acc[2][8], acc2[2][8];
#pragma unroll
    for (int i = 0; i < 2; ++i)
#pragma unroll
        for (int j = 0; j < 8; ++j) { acc[i][j] = 0.f; acc2[i][j] = 0.f; }
    int srow = lr; if (gath) srow = (lr < gcount) ? (gath[lr] >> 1) : 0;
    const bf16* ap = A + (size_t)srow * lda + lc;
    const bf16* bp = B + (size_t)(lr & 63) * ldb + lc;
    const bf16* bp2 = DUAL ? (B2 + (size_t)(lr & 63) * ldb + lc) : bp;
    for (int k0 = 0; k0 < K; k0 += 32) {
        const u32x4 av = *(const u32x4*)(ap + k0);
        u32x4 bv = (u32x4){0, 0, 0, 0}, bv2 = (u32x4){0, 0, 0, 0};
        if (t < 256) { bv = *(const u32x4*)(bp + k0); if (DUAL) bv2 = *(const u32x4*)(bp2 + k0); }
        __syncthreads();
        { float v[8]; unpack8(av, v);
#pragma unroll
          for (int i = 0; i < 8; ++i) As[(lc + i) * 132 + lr] = v[i]; }
        if (t < 256) { float v[8]; unpack8(bv, v);
#pragma unroll
          for (int i = 0; i < 8; ++i) Bs[(lc + i) * 68 + lr] = v[i];
          if (DUAL) { unpack8(bv2, v);
#pragma unroll
            for (int i = 0; i < 8; ++i) Bs2[(lc + i) * 68 + lr] = v[i]; } }
        __syncthreads();
#pragma unroll 4
        for (int k = 0; k < 32; ++k) {
            const f32x2 a = *(const f32x2*)(As + k * 132 + 2 * ty);
            const f32x4 b0 = *(const f32x4*)(Bs + k * 68 + 8 * tx), b1 = *(const f32x4*)(Bs + k * 68 + 8 * tx + 4);
            const float bb[8] = {b0.x, b0.y, b0.z, b0.w, b1.x, b1.y, b1.z, b1.w};
#pragma unroll
            for (int j = 0; j < 8; ++j) { acc[0][j] = fmaf(a.x, bb[j], acc[0][j]); acc[1][j] = fmaf(a.y, bb[j], acc[1][j]); }
            if (DUAL) { const f32x4 c0 = *(const f32x4*)(Bs2 + k * 68 + 8 * tx), c1 = *(const f32x4*)(Bs2 + k * 68 + 8 * tx + 4);
                const float cc[8] = {c0.x, c0.y, c0.z, c0.w, c1.x, c1.y, c1.z, c1.w};
#pragma unroll
                for (int j = 0; j < 8; ++j) { acc2[0][j] = fmaf(a.x, cc[j], acc2[0][j]); acc2[1][j] = fmaf(a.y, cc[j], acc2[1][j]); } }
        }
    }
    __syncthreads();
    epi(2 * ty, 8 * tx, acc[0], acc2[0]); epi(2 * ty + 1, 8 * tx, acc[1], acc2[1]);
}
template <class EpiF>
__device__ __forceinline__ void ngemm_dense(Frame& F, const bf16* A, int lda, const bf16* B, int ldb, int M, int N, int K, const EpiF& epif) {
    const int ntn = N / 64, nt = (M / 128) * ntn;
    for (int it = F.bid; it < nt; it += F.G) { const int tm = it / ntn, tn = it % ntn;
        auto epi = [&](int r, int c, const float (&v)[8], const float (&v2)[8]) { epif(tm * 128 + r, tn * 64 + c, v); };
        ngemm_tile<false>(F.lds, A + (size_t)tm * 128 * lda, lda, nullptr, 0, B + (size_t)tn * 64 * ldb, nullptr, ldb, K, epi); }
}

__device__ __forceinline__ float rinv_from_ssq(const float* ssq_row, int g0, int ng, float inv_n) {
    float s = 0.f;
    for (int g = 0; g < ng; ++g) s += ssq_row[g0 + g];
    return 1.f / sqrtf(s * inv_n + EPS);
}
__device__ __forceinline__ void p1_ssq_from_z(Frame& F) {
    const int gt = F.bid * NTHREADS + F.tid, NGT = F.G * NTHREADS;
    for (int i = gt; i < NTOK * 20; i += NGT) { const int m = i / 20, g = i % 20; const u32x4* zp = (const u32x4*)(F.Z + (size_t)m * ZC + 32 * g);
        float s = 0.f;
#pragma unroll
        for (int j = 0; j < 4; ++j) { float v[8]; unpack8(zp[j], v);
#pragma unroll
            for (int q = 0; q < 8; ++q) s += v[q] * v[q]; }
        F.SSQ[m * 32 + g] = s; }
}
__device__ __forceinline__ void p2_krope_conv(Frame& F) {
    const int gt = F.bid * NTHREADS + F.tid, NGT = F.G * NTHREADS;
    for (int i = gt; i < NTOK * 4; i += NGT) { const int m = i >> 2, g = i & 3, b = m / SEQ, s = m % SEQ;
        const bf16* kr = F.Z + (size_t)m * ZC + KR0; const float* rp = F.ROPE + m * 32;
        float o[8];
#pragma unroll
        for (int j = 0; j < 4; ++j) { const int ii = 4 * g + j; const float x1 = bf2f(kr[ii]), x2 = bf2f(kr[16 + ii]), c = rp[ii], sn = rp[16 + ii];
            o[j] = x1 * c - x2 * sn; o[4 + j] = x2 * c + x1 * sn; }
        const u32x4 w = pack8(o);
#pragma unroll
        for (int h = 0; h < NH; ++h) *(u32x4*)(F.K + ((size_t)(b * NH + h) * SEQ + s) * DQK + 64 + 8 * g) = w; }
    const int gw = F.bid * NWAVES + F.wave, NGW = F.G * NWAVES, lane = F.lane;
    float w0[8], w1[8], w2[8];
#pragma unroll
    for (int j = 0; j < 8; ++j) { w0[j] = F.conv_w[8 * lane + j]; w1[j] = F.conv_w[CONVW + 8 * lane + j]; w2[j] = F.conv_w[2 * CONVW + 8 * lane + j]; }
    for (int run = gw; run < NTOK / 16; run += NGW) { const int m0 = run * 16, s0 = m0 % SEQ;
        float cm2[8], cm1[8];
#pragma unroll
        for (int j = 0; j < 8; ++j) { cm2[j] = 0.f; cm1[j] = 0.f; }
        if (s0 >= 2) {
            float a[8], u[8];
            unpack8(*(const u32x4*)(F.Z + (size_t)(m0 - 2) * ZC + CG0 + 8 * lane), a); unpack8(*(const u32x4*)(F.Z + (size_t)(m0 - 2) * ZC + U0 + 8 * lane), u);
#pragma unroll
            for (int j = 0; j < 8; ++j) cm2[j] = a[j] * u[j];
            unpack8(*(const u32x4*)(F.Z + (size_t)(m0 - 1) * ZC + CG0 + 8 * lane), a); unpack8(*(const u32x4*)(F.Z + (size_t)(m0 - 1) * ZC + U0 + 8 * lane), u);
#pragma unroll
            for (int j = 0; j < 8; ++j) cm1[j] = a[j] * u[j];
        }
        for (int tt = 0; tt < 16; ++tt) { const int m = m0 + tt; const bf16* zr = F.Z + (size_t)m * ZC;
            float bg[8], cg[8], u[8], o[8];
            unpack8(*(const u32x4*)(zr + BG0 + 8 * lane), bg); unpack8(*(const u32x4*)(zr + CG0 + 8 * lane), cg); unpack8(*(const u32x4*)(zr + U0 + 8 * lane), u);
#pragma unroll
            for (int j = 0; j < 8; ++j) { const float cu = cg[j] * u[j]; o[j] = bg[j] * (w0[j] * cm2[j] + w1[j] * cm1[j] + w2[j] * cu); cm2[j] = cm1[j]; cm1[j] = cu; }
            *(u32x4*)(F.RA + (size_t)m * D + 512 + 8 * lane) = pack8(o); }
    }
}
__device__ __forceinline__ void p5_route(Frame& F) {
    int* lcnt = (int*)F.lds;
    int* gbase = lcnt + 32;
    int* sel = gbase + 32;
    const int lane = F.lane;
    for (int chunk = F.bid; chunk < NTOK / 128; chunk += F.G) {
        if (F.tid < 32) lcnt[F.tid] = 0;
        __syncthreads();
        for (int tt = 0; tt < 16; ++tt) { const int tl = F.wave * 16 + tt, m = chunk * 128 + tl;
            const f32x4* hr = (const f32x4*)(F.out + (size_t)m * D) + lane; const f32x4* gr = (const f32x4*)F.moe_g + lane;
            f32x4 v[4]; float s = 0.f;
#pragma unroll
            for (int j = 0; j < 4; ++j) { v[j] = hr[64 * j]; s += (v[j].x * v[j].x + v[j].y * v[j].y) + (v[j].z * v[j].z + v[j].w * v[j].w); }
            const float rinv = 1.f / sqrtf(wave_sum(s) * (1.f / D) + EPS);
            u32x2* o8 = (u32x2*)(F.RA + (size_t)m * D) + lane;
#pragma unroll
            for (int j = 0; j < 4; ++j) { const f32x4 gg = gr[64 * j]; v[j].x = v[j].x * rinv * gg.x; v[j].y = v[j].y * rinv * gg.y; v[j].z = v[j].z * rinv * gg.z; v[j].w = v[j].w * rinv * gg.w;
                u32x2 o; o.x = pk2(v[j].x, v[j].y); o.y = pk2(v[j].z, v[j].w); o8[64 * j] = o; }
            float lg[4];
#pragma unroll
            for (int i = 0; i < 4; ++i) { const f32x4* wr = (const f32x4*)(F.RWT + i * D) + lane; float a = 0.f;
#pragma unroll
                for (int j = 0; j < 4; ++j) { const f32x4 w = wr[64 * j]; a = fmaf(v[j].x, w.x, a); a = fmaf(v[j].y, w.y, a); a = fmaf(v[j].z, w.z, a); a = fmaf(v[j].w, w.w, a); }
                lg[i] = wave_sum(a) + F.b_gr[i]; }
            int gi = 0; float gm = lg[0];
#pragma unroll
            for (int i = 1; i < 4; ++i) if (lg[i] > gm) { gm = lg[i]; gi = i; }
            float gs = 0.f;
#pragma unroll
            for (int i = 0; i < 4; ++i) gs += __expf(lg[i] - gm);
            const float gp = 1.f / gs;
            gi = __builtin_amdgcn_readfirstlane(gi);
            float le[8];
#pragma unroll
            for (int i = 0; i < 8; ++i) { const f32x4* wr = (const f32x4*)(F.RWT + (4 + gi * 8 + i) * D) + lane; float a = 0.f;
#pragma unroll
                for (int j = 0; j < 4; ++j) { const f32x4 w = wr[64 * j]; a = fmaf(v[j].x, w.x, a); a = fmaf(v[j].y, w.y, a); a = fmaf(v[j].z, w.z, a); a = fmaf(v[j].w, w.w, a); }
                le[i] = wave_sum(a) + F.b_er[gi * 8 + i]; }
            int e0 = 0; float m0 = le[0];
#pragma unroll
            for (int i = 1; i < 8; ++i) if (le[i] > m0) { m0 = le[i]; e0 = i; }
            int e1 = -1; float m1 = -3.0e38f;
#pragma unroll
            for (int i = 0; i < 8; ++i) if (i != e0 && le[i] > m1) { m1 = le[i]; e1 = i; }
            const float p1 = __expf(m1 - m0), den = 1.f / (1.f + p1);
            if (lane == 0) {
                F.AW[2 * m] = gp * den; F.AW[2 * m + 1] = gp * p1 * den;
                const int E0 = gi * 8 + e0, E1 = gi * 8 + e1;
                const int q0 = atomicAdd(&lcnt[E0], 1), q1 = atomicAdd(&lcnt[E1], 1);
                sel[2 * tl] = (E0 << 16) | q0; sel[2 * tl + 1] = (E1 << 16) | q1;
            }
        }
        __syncthreads();
        if (F.tid < 32) gbase[F.tid] = (int)__hip_atomic_fetch_add(F.ctl + CW_CNT + F.tid, (unsigned)lcnt[F.tid], __ATOMIC_RELAXED, __HIP_MEMORY_SCOPE_AGENT);
        __syncthreads();
        if (F.tid < 256) { const int sv = sel[F.tid], e = sv >> 16, q = sv & 0xffff, m = chunk * 128 + (F.tid >> 1);
            F.LIST[e * LISTCAP + gbase[e] + q] = (m << 1) | (F.tid & 1); }
        __syncthreads();
    }
}
__device__ __forceinline__ void moe_tile_table(Frame& F, int* tb, int* cnts) {
    if (F.tid == 0) { int acc = 0; for (int e = 0; e < NEXP; ++e) { const int c = (int)__hip_atomic_load(F.ctl + CW_CNT + e, __ATOMIC_RELAXED, __HIP_MEMORY_SCOPE_AGENT); cnts[e] = c; tb[e] = acc; acc += (c + 255) >> 8; } tb[NEXP] = acc; }
    __syncthreads();
}
__device__ __forceinline__ void p8_combine(Frame& F) {
    const int gw = F.bid * NWAVES + F.wave, NGW = F.G * NWAVES, lane = F.lane;
    for (int m = gw; m < NTOK; m += NGW) {
        f32x4* hr = (f32x4*)(F.out + (size_t)m * D) + lane; const f32x4* gr = (const f32x4*)F.ple_g + lane;
        const u32x2* y0 = (const u32x2*)(F.YBUF + (size_t)(2 * m) * D) + lane; const u32x2* y1 = (const u32x2*)(F.YBUF + (size_t)(2 * m + 1) * D) + lane;
        f32x4 v[4]; float s = 0.f;
#pragma unroll
        for (int j = 0; j < 4; ++j) { v[j] = hr[64 * j]; const u32x2 a = y0[64 * j], b = y1[64 * j];
            v[j].x += bflo(a.x) + bflo(b.x); v[j].y += bfhi(a.x) + bfhi(b.x); v[j].z += bflo(a.y) + bflo(b.y); v[j].w += bfhi(a.y) + bfhi(b.y);
            hr[64 * j] = v[j]; s += (v[j].x * v[j].x + v[j].y * v[j].y) + (v[j].z * v[j].z + v[j].w * v[j].w); }
        const float rinv = 1.f / sqrtf(wave_sum(s) * (1.f / D) + EPS);
        u32x2* o8 = (u32x2*)(F.RA + (size_t)m * D) + lane;
#pragma unroll
        for (int j = 0; j < 4; ++j) { const f32x4 gg = gr[64 * j]; u32x2 o; o.x = pk2(v[j].x * rinv * gg.x, v[j].y * rinv * gg.y); o.y = pk2(v[j].z * rinv * gg.z, v[j].w * rinv * gg.w); o8[64 * j] = o; }
    }
}
__device__ __forceinline__ void p10_final(Frame& F) {
    const int gw = F.bid * NWAVES + F.wave, NGW = F.G * NWAVES, lane = F.lane;
    for (int m = gw; m < NTOK; m += NGW) {
        f32x4* hr = (f32x4*)(F.out + (size_t)m * D) + lane; const f32x4* gr = (const f32x4*)F.fin_g + lane;
        f32x4 v[4]; float s = 0.f;
#pragma unroll
        for (int j = 0; j < 4; ++j) { v[j] = hr[64 * j]; s += (v[j].x * v[j].x + v[j].y * v[j].y) + (v[j].z * v[j].z + v[j].w * v[j].w); }
        const float rinv = 1.f / sqrtf(wave_sum(s) * (1.f / D) + EPS);
#pragma unroll
        for (int j = 0; j < 4; ++j) { const f32x4 gg = gr[64 * j]; f32x4 o; o.x = v[j].x * rinv * gg.x; o.y = v[j].y * rinv * gg.y; o.z = v[j].z * rinv * gg.z; o.w = v[j].w * rinv * gg.w; hr[64 * j] = o; }
    }
}

__device__ __forceinline__ void epi_q(Frame& F, int row, int col, const float (&v)[8]) {
    const float rinv = rinv_from_ssq(F.SSQ + row * 32, 0, 12, 1.f / QLORA);
    const int h = col / 96, p = col % 96, b = row / SEQ, s = row % SEQ; float o[8];
    if (p < 64) {
#pragma unroll
        for (int j = 0; j < 8; ++j) o[j] = v[j] * rinv * QSCALE;
    } else { const int g = (p - 64) >> 3; const float* rp = F.ROPE + row * 32;
#pragma unroll
        for (int j = 0; j < 4; ++j) { const int ii = 4 * g + j; const float x1 = v[j] * rinv, x2 = v[4 + j] * rinv, c = rp[ii], sn = rp[16 + ii];
            o[j] = (x1 * c - x2 * sn) * QSCALE; o[4 + j] = (x2 * c + x1 * sn) * QSCALE; } }
    *(u32x4*)(F.Q + ((size_t)(b * NH + h) * SEQ + s) * DQK + p) = pack8(o);
}
__device__ __forceinline__ void epi_kv(Frame& F, int row, int col, const float (&v)[8]) {
    const float rinv = rinv_from_ssq(F.SSQ + row * 32, 12, 8, 1.f / KVLORA);
    const int h = col >> 7, d = col & 127, b = row / SEQ, s = row % SEQ; float o[8];
#pragma unroll
    for (int j = 0; j < 8; ++j) o[j] = v[j] * rinv;
    if (d < 64) *(u32x4*)(F.K + ((size_t)(b * NH + h) * SEQ + s) * DQK + d) = pack8(o);
    else        *(u32x4*)(F.V + ((size_t)(b * NH + h) * SEQ + s) * DV + (d - 64)) = pack8(o);
}

__device__ __forceinline__ void nattn_item(Frame& F, int bh, int qb) {
    const int q = qb * 512 + F.tid;
    const int qlast = __builtin_amdgcn_readfirstlane(qb * 512 + F.wave * 64 + 63);
    float qv[96], o[64];
    { const u32x4* qp = (const u32x4*)(F.Q + ((size_t)bh * SEQ + q) * DQK);
#pragma unroll
      for (int c = 0; c < 12; ++c) { float t[8]; unpack8(qp[c], t);
#pragma unroll
          for (int j = 0; j < 8; ++j) qv[8 * c + j] = t[j]; } }
#pragma unroll
    for (int d = 0; d < 64; ++d) o[d] = 0.f;
    float m = -1e30f, l = 0.f;
    const bf16* Kb = F.K + (size_t)bh * SEQ * DQK; const bf16* Vb = F.V + (size_t)bh * SEQ * DV;
    for (int j = 0; j <= qlast; ++j) {
        const u32x4* kp = (const u32x4*)(Kb + (size_t)j * DQK);
        float s = 0.f;
#pragma unroll
        for (int c = 0; c < 12; ++c) { float t[8]; unpack8(kp[c], t);
#pragma unroll
            for (int i = 0; i < 8; ++i) s = fmaf(qv[8 * c + i], t[i], s); }
        if (j <= q) {
            if (s > m) { const float cf = exp2f(m - s); l *= cf;
#pragma unroll
                for (int d = 0; d < 64; ++d) o[d] *= cf;
                m = s; }
            const float pj = exp2f(s - m); l += pj;
            const u32x4* vp = (const u32x4*)(Vb + (size_t)j * DV);
#pragma unroll
            for (int c = 0; c < 8; ++c) { float t[8]; unpack8(vp[c], t);
#pragma unroll
                for (int i = 0; i < 8; ++i) o[8 * c + i] = fmaf(pj, t[i], o[8 * c + i]); }
        }
    }
    const float il = 1.f / l; const int b = bh / NH, h = bh % NH;
    bf16* op = F.RA + ((size_t)b * SEQ + q) * D + h * DV;
#pragma unroll
    for (int c = 0; c < 8; ++c) { float t[8];
#pragma unroll
        for (int i = 0; i < 8; ++i) t[i] = o[8 * c + i] * il;
        *(u32x4*)(op + 8 * c) = pack8(t); }
}

__global__ void __launch_bounds__(NTHREADS, 2) fwd(Args args) {
    extern __shared__ __attribute__((aligned(16))) char lds[];
    Frame F;
    F.lds = lds; F.tid = threadIdx.x; F.lane = F.tid & 63; F.wave = __builtin_amdgcn_readfirstlane(F.tid >> 6); F.G = gridDim.x; F.bid = blockIdx.x;
    unsigned char* ws = args.ws;
    F.ctl = (unsigned*)(ws + WS_CTL);
    F.x = (const float*)args.in[0]; F.p = (const float*)args.in[1]; F.pos = (const int*)args.in[2]; F.attn_g = (const float*)args.in[3]; F.w_in = (const float*)args.in[4];
    F.q_g = (const float*)args.in[5]; F.w_uq = (const float*)args.in[6]; F.kv_g = (const float*)args.in[7]; F.w_ukv = (const float*)args.in[8]; F.conv_w = (const float*)args.in[9];
    F.w_out = (const float*)args.in[10]; F.moe_g = (const float*)args.in[11]; F.w_gr = (const float*)args.in[12]; F.b_gr = (const float*)args.in[13]; F.w_er = (const float*)args.in[14];
    F.b_er = (const float*)args.in[15]; F.w_gate = (const float*)args.in[16]; F.w_up = (const float*)args.in[17]; F.w_down = (const float*)args.in[18]; F.ple_g = (const float*)args.in[19];
    F.w_pg = (const float*)args.in[20]; F.b_pg = (const float*)args.in[21]; F.w_pp = (const float*)args.in[22]; F.fin_g = (const float*)args.in[23];
    F.out = args.out;
    F.WinT = (bf16*)(ws + WS_WIN); F.WuqT = (bf16*)(ws + WS_WUQ); F.WukvT = (bf16*)(ws + WS_WUKV); F.WoutT = (bf16*)(ws + WS_WOUT); F.WpgT = (bf16*)(ws + WS_WPG); F.WppT = (bf16*)(ws + WS_WPP);
    F.WguT = (bf16*)(ws + WS_WGU); F.WdT = (bf16*)(ws + WS_WD); F.PB = (bf16*)(ws + WS_PB); F.RA = (bf16*)(ws + WS_A); F.Z = (bf16*)(ws + WS_B); F.HBUF = (bf16*)(ws + WS_B);
    F.PROJ = (bf16*)(ws + WS_B + OFF_PROJ); F.Q = (bf16*)(ws + WS_C); F.K = (bf16*)(ws + WS_C + OFF_K); F.V = (bf16*)(ws + WS_C + OFF_V); F.YBUF = (bf16*)(ws + WS_C);
    F.RWT = (float*)(ws + WS_RWT); F.ROPE = (float*)(ws + WS_ROPE); F.SSQ = (float*)(ws + WS_SSQ); F.AW = (float*)(ws + WS_AW); F.LIST = (int*)(ws + WS_LIST);

    for (int u = F.tid; u < (LDS_BYTES - LDS_MISC) / 4; u += NTHREADS) ((unsigned*)(lds + LDS_MISC))[u] = 0u;
    __syncthreads();
    volatile LAS unsigned* MISC = (volatile LAS unsigned*)(LAS char*)(lds + LDS_MISC);
    XcdBarrier bar = xcd_barrier_post(F.ctl + CW_BAR + args.ph_lo * XCD_BAR_WORDS, MISC + 8);
    const int lo = args.ph_lo, hi = args.ph_hi;
#define IN(k) (lo <= (k) && (k) < hi)
#define SEAM(k) do { if (IN(k) && IN((k) + 1)) xcd_barrier(bar); } while (0)

    if (IN(0)) { p0_prologue(F); } SEAM(0);
    if (IN(1)) {
        auto ez = [&](int row, int col, const float (&v)[8]) { *(u32x4*)(F.Z + (size_t)row * ZC + col) = pack8(v); };
        ngemm_dense(F, F.RA, D, F.WinT, D, NTOK, ZC, D, ez);
        xcd_barrier(bar);
        p1_ssq_from_z(F);
    } SEAM(1);
    if (IN(2)) {
        auto eq = [&](int row, int col, const float (&v)[8]) { epi_q(F, row, col, v); };
        ngemm_dense(F, F.Z + CQ0, ZC, F.WuqT, QLORA, NTOK, 768, QLORA, eq);
        auto ekv = [&](int row, int col, const float (&v)[8]) { epi_kv(F, row, col, v); };
        ngemm_dense(F, F.Z + CKV0, ZC, F.WukvT, KVLORA, NTOK, 1024, KVLORA, ekv);
        p2_krope_conv(F);
    } SEAM(2);
    if (IN(3)) {
        for (int it = F.bid; it < 256; it += F.G) { const int bh = it & 31, s = it >> 5;
            nattn_item(F, bh, s); nattn_item(F, bh, 15 - s); }
    } SEAM(3);
    if (IN(4)) {
        auto eh = [&](int row, int col, const float (&v)[8]) { const f32x4* xp = (const f32x4*)(F.x + (size_t)row * D + col); f32x4* op = (f32x4*)(F.out + (size_t)row * D + col);
            const f32x4 a = xp[0], b = xp[1]; op[0] = (f32x4){a.x + v[0], a.y + v[1], a.z + v[2], a.w + v[3]}; op[1] = (f32x4){b.x + v[4], b.y + v[5], b.z + v[6], b.w + v[7]}; };
        ngemm_dense(F, F.RA, D, F.WoutT, D, NTOK, D, D, eh);
    } SEAM(4);
    if (IN(5)) { p5_route(F); } SEAM(5);
    if (IN(6)) {
        int* tb = (int*)(lds + 65536); int* cnts = tb + 40;
        moe_tile_table(F, tb, cnts);
        const int nrt = tb[NEXP], nit = nrt * 2 * 8;
        for (int it = F.bid; it < nit; it += F.G) { const int ct = it & 7, hf = (it >> 3) & 1, R = it >> 4;
            int e = 0; while (tb[e + 1] <= R) ++e;
            const int pos0 = (R - tb[e]) * 256 + hf * 128, cnt = cnts[e];
            bf16* hb = F.HBUF + ((size_t)R * 256 + hf * 128) * FF + ct * 64;
            auto epi = [&](int r, int c, const float (&g)[8], const float (&u)[8]) { float o[8];
#pragma unroll
                for (int j = 0; j < 8; ++j) o[j] = g[j] / (1.f + __expf(-g[j])) * u[j];
                *(u32x4*)(hb + (size_t)r * FF + c) = pack8(o); };
            const int j0 = ct * 64; const bf16* Bg = F.WguT + (size_t)e * 1024 * 1024 + (size_t)(256 * (j0 >> 7) + (j0 & 127)) * D;
            ngemm_tile<true>(F.lds, F.RA, D, F.LIST + e * LISTCAP + pos0, cnt - pos0, Bg, Bg + (size_t)128 * D, D, D, epi); }
    } SEAM(6);
    if (IN(7)) {
        int* tb = (int*)(lds + 65536); int* cnts = tb + 40;
        moe_tile_table(F, tb, cnts);
        const int nrt = tb[NEXP], nit = nrt * 2 * 16;
        for (int it = F.bid; it < nit; it += F.G) { const int ct = it & 15, hf = (it >> 4) & 1, R = it >> 5;
            int e = 0; while (tb[e + 1] <= R) ++e;
            const int pos0 = (R - tb[e]) * 256 + hf * 128, cnt = cnts[e];
            const int* lst = F.LIST + e * LISTCAP + pos0;
            auto epi = [&](int r, int c, const float (&v)[8], const float (&v2)[8]) { if (pos0 + r < cnt) { const int a = lst[r]; const float w = F.AW[a]; float o[8];
#pragma unroll
                for (int j = 0; j < 8; ++j) o[j] = v[j] * w;
                *(u32x4*)(F.YBUF + (size_t)a * D + ct * 64 + c) = pack8(o); } };
            ngemm_tile<false>(F.lds, F.HBUF + ((size_t)R * 256 + hf * 128) * FF, FF, nullptr, 0, F.WdT + (size_t)e * 1024 * 512 + (size_t)ct * 64 * FF, nullptr, FF, FF, epi); }
    } SEAM(7);
    if (IN(8)) {
        p8_combine(F);
        auto ep = [&](int row, int col, const float (&v)[8]) { *(u32x4*)(F.PROJ + (size_t)row * D + col) = pack8(v); };
        ngemm_dense(F, F.PB, PLE, F.WppT, PLE, NTOK, D, PLE, ep);
    } SEAM(8);
    if (IN(9)) {
        auto eg = [&](int row, int col, const float (&v)[8]) { f32x4* op = (f32x4*)(F.out + (size_t)row * D + col); float pr[8]; unpack8(*(const u32x4*)(F.PROJ + (size_t)row * D + col), pr);
            f32x4 a = op[0], b = op[1]; float o[8] = {a.x, a.y, a.z, a.w, b.x, b.y, b.z, b.w};
#pragma unroll
            for (int j = 0; j < 8; ++j) o[j] += pr[j] / (1.f + __expf(-(v[j] + F.b_pg[col + j])));
            op[0] = (f32x4){o[0], o[1], o[2], o[3]}; op[1] = (f32x4){o[4], o[5], o[6], o[7]}; };
        ngemm_dense(F, F.RA, D, F.WpgT, D, NTOK, D, D, eg);
    } SEAM(9);
    if (IN(10)) { p10_final(F); }
#undef IN
#undef SEAM
}

extern "C" void kernel_launch(void* const* d_in, const int* in_sizes, int n_in, void* d_out, int out_size, void* d_ws, size_t ws_size, hipStream_t stream) {
    static int grid = 0;
    if (grid == 0) {
        if (n_in != 24 || out_size != NTOK * D || ws_size < WS_END) { fprintf(stderr, "kernel_launch: unexpected shapes (n_in %d out %d ws %zu)\n", n_in, out_size, ws_size); grid = -1; return; }
        int dev = 0, cus = 0, per_cu = 0;
        if (hipGetDevice(&dev) != hipSuccess || hipDeviceGetAttribute(&cus, hipDeviceAttributeMultiprocessorCount, dev) != hipSuccess) { grid = -1; return; }
        if (hipFuncSetAttribute((const void*)fwd, hipFuncAttributeMaxDynamicSharedMemorySize, LDS_BYTES) != hipSuccess) { fprintf(stderr, "kernel_launch: hipFuncSetAttribute failed\n"); grid = -1; return; }
        if (hipOccupancyMaxActiveBlocksPerMultiprocessor(&per_cu, (const void*)fwd, NTHREADS, LDS_BYTES) != hipSuccess || per_cu < 1) fprintf(stderr, "kernel_launch: occupancy query says %d\n", per_cu);
        (void)hipGetLastError();
        grid = cus;
    }
    if (grid < 0) return;
    (void)hipMemsetAsync((char*)d_ws + WS_CTL, 0, CTL_ZERO_BYTES, stream);
    Args a{};
    for (int i = 0; i < 24; ++i) a.in[i] = d_in[i];
    a.out = (float*)d_out; a.ws = (unsigned char*)d_ws;
#ifndef MK_SPLIT
    a.ph_lo = 0; a.ph_hi = 11;
    hipLaunchKernelGGL(fwd, dim3(grid), dim3(NTHREADS), LDS_BYTES, stream, a);
#else
    for (int k = 0; k < 11; ++k) { a.ph_lo = k; a.ph_hi = k + 1; hipLaunchKernelGGL(fwd, dim3(grid), dim3(NTHREADS), LDS_BYTES, stream, a); }
#endif
}
```

```cpp
#include <hip/hip_runtime.h>
#include <hip/hip_bf16.h>
#include <cmath>
#include <cstdio>
#include <cstdint>

#define GAS __attribute__((address_space(1)))
#define LAS __attribute__((address_space(3)))
typedef unsigned short bf16;
typedef unsigned u32x4 __attribute__((ext_vector_type(4)));
typedef unsigned u32x2 __attribute__((ext_vector_type(2)));
typedef float f32x4 __attribute__((ext_vector_type(4)));
typedef float f32x2 __attribute__((ext_vector_type(2)));

constexpr int BATCH = 4, SEQ = 8192, NTOK = BATCH * SEQ, D = 1024, PLE = 256;
constexpr int NH = 8, DQK = 96, DV = 64, QLORA = 384, KVLORA = 256, ROPE_D = 32, CONVW = 512;
constexpr int ZN = 2208, ZC = 2304;
constexpr int CQ0 = 0, CKV0 = 384, KR0 = 640, BG0 = 672, CG0 = 1184, U0 = 1696;
constexpr int NEXP = 32, EPG = 8, NGRP = 4, FF = 512;
constexpr int LISTCAP = 32768;
constexpr int MAXRT = 320;
constexpr float EPS = 1e-6f;
constexpr float QSCALE = 0.14724444602590306f;
constexpr int NTHREADS = 512, NWAVES = 8;
#ifndef OPT
#define OPT 0x3DE
#endif
#define OPTP(k) (((OPT) >> (k)) & 1)

constexpr size_t MiB = 1u << 20;
constexpr size_t WS_CTL = 0, CTL_ZERO_BYTES = 1 * MiB;
constexpr size_t WS_WIN = 1 * MiB;
constexpr size_t WS_WUQ = 6 * MiB;
constexpr size_t WS_WUKV = 7 * MiB;
constexpr size_t WS_WOUT = 8 * MiB;
constexpr size_t WS_WPG = 10 * MiB;
constexpr size_t WS_WPP = 12 * MiB;
constexpr size_t WS_RWT = 13 * MiB;
constexpr size_t WS_ROPE = 14 * MiB;
constexpr size_t WS_SSQ = 18 * MiB;
constexpr size_t WS_LIST = 22 * MiB;
constexpr size_t WS_AW = 26 * MiB;
constexpr size_t WS_WGU = 28 * MiB;
constexpr size_t WS_WD = 92 * MiB;
constexpr size_t WS_PB = 124 * MiB;
constexpr size_t WS_A = 140 * MiB;
constexpr size_t WS_B = 204 * MiB;
constexpr size_t WS_C = 348 * MiB;
constexpr size_t WS_END = 476 * MiB;
constexpr size_t OFF_K = 48 * MiB, OFF_V = 96 * MiB, OFF_PROJ = 80 * MiB;

constexpr int CW_BAR = 4096;
constexpr int CW_CNT = 49152;

constexpr int LDS_BYTES = 147456;
constexpr int LDS_MISC = 131072;

__device__ __forceinline__ unsigned f2bf(float f) { unsigned u = __builtin_bit_cast(unsigned, f); return (u + 0x7fffu + ((u >> 16) & 1u)) >> 16; }
__device__ __forceinline__ unsigned pk2(float lo, float hi) { return f2bf(lo) | (f2bf(hi) << 16); }
__device__ __forceinline__ float bflo(unsigned w) { return __builtin_bit_cast(float, w << 16); }
__device__ __forceinline__ float bfhi(unsigned w) { return __builtin_bit_cast(float, w & 0xffff0000u); }
__device__ __forceinline__ float bf2f(bf16 b) { return __builtin_bit_cast(float, (unsigned)b << 16); }
__device__ __forceinline__ void unpack8(const u32x4 w, float (&v)[8]) {
    v[0] = bflo(w.x); v[1] = bfhi(w.x); v[2] = bflo(w.y); v[3] = bfhi(w.y); v[4] = bflo(w.z); v[5] = bfhi(w.z); v[6] = bflo(w.w); v[7] = bfhi(w.w); }
__device__ __forceinline__ u32x4 pack8(const float (&v)[8]) { u32x4 w; w.x = pk2(v[0], v[1]); w.y = pk2(v[2], v[3]); w.z = pk2(v[4], v[5]); w.w = pk2(v[6], v[7]); return w; }
typedef __bf16 bf16x2_t __attribute__((ext_vector_type(2)));
__device__ __forceinline__ unsigned pkf(float lo, float hi) { f32x2 v = {lo, hi}; bf16x2_t b = __builtin_convertvector(v, bf16x2_t); return __builtin_bit_cast(unsigned, b); }
__device__ __forceinline__ u32x4 pack8f(const float (&v)[8]) { u32x4 w; w.x = pkf(v[0], v[1]); w.y = pkf(v[2], v[3]); w.z = pkf(v[4], v[5]); w.w = pkf(v[6], v[7]); return w; }
__device__ __forceinline__ float wave_sum(float v) {
#pragma unroll
    for (int o = 1; o < 64; o <<= 1) v += __shfl_xor(v, o);
    return v;
}

#define XB_TMO      128
#define XB_XCNT(j)  (256  + 64 * (j))
#define XB_XSUB(j)  (1280 + 64 * (j))
#define XB_XGEN(j)  (2304 + 64 * (j))
#define XB_TOP      3328
#define XB_TOPGEN   3392
#define XCD_BAR_WORDS 3456
#define XB_SPIN_CAP (1u << 23)
__device__ __forceinline__ unsigned xb_ld(unsigned* p)              { return __hip_atomic_load(p, __ATOMIC_RELAXED, __HIP_MEMORY_SCOPE_AGENT); }
__device__ __forceinline__ unsigned xb_add(unsigned* p, unsigned v) { return __hip_atomic_fetch_add(p, v, __ATOMIC_RELAXED, __HIP_MEMORY_SCOPE_AGENT); }
__device__ __forceinline__ unsigned xb_xcc_id() { return (unsigned)__builtin_amdgcn_s_getreg((3 << 11) | 20) & 0xFu; }
#define XB_SPIN(cond, bar) do { unsigned _sp = 0; while (cond) { __builtin_amdgcn_s_sleep(1); \
    if ((++_sp & 255u) == 0u) { if (xb_ld(&(bar)[XB_TMO])) break; if (_sp > XB_SPIN_CAP) { atomicAdd(&(bar)[XB_TMO], 1u); break; } } } } while (0)
struct XcdBarrier { unsigned* bar; unsigned x; volatile LAS unsigned* st; };
__device__ __forceinline__ XcdBarrier xcd_barrier_post(unsigned* bar, volatile LAS unsigned* st) {
    XcdBarrier b; b.bar = bar; b.x = xb_xcc_id(); b.st = st;
    if (threadIdx.x == 0) (void)xb_add(&bar[XB_XCNT(b.x)], 1u);
    return b;
}
__device__ __forceinline__ void xcd_barrier_complete(unsigned* bar, unsigned x, unsigned& nloc, unsigned& nx) {
    const unsigned G = gridDim.x * gridDim.y * gridDim.z;
    unsigned sum, cnt, mine, sp = 0u;
    for (;;) {
        sum = 0u; cnt = 0u; mine = 0u;
#pragma unroll
        for (unsigned j = 0; j < 16; ++j) { const unsigned c = xb_ld(&bar[XB_XCNT(j)]); sum += c; cnt += (c > 0u) ? 1u : 0u; mine = (j == x) ? c : mine; }
        if (sum == G) break;
        __builtin_amdgcn_s_sleep(1);
        if ((++sp & 255u) == 0u) { if (xb_ld(&bar[XB_TMO])) break; if (sp > XB_SPIN_CAP) { atomicAdd(&bar[XB_TMO], 1u); break; } }
    }
    nloc = mine > 0u ? mine : 1u; nx = cnt > 0u ? cnt : 1u;
}
__device__ __forceinline__ void xcd_barrier(const XcdBarrier& b) {
    asm volatile("s_waitcnt vmcnt(0)" ::: "memory");
    __syncthreads();
    if (threadIdx.x == 0) {
        unsigned* bar = b.bar;
        __builtin_amdgcn_s_waitcnt(0);
        unsigned nloc = b.st[0], nx = b.st[1];
        if (nloc == 0u) { xcd_barrier_complete(bar, b.x, nloc, nx); b.st[0] = nloc; b.st[1] = nx; }
        const unsigned old = xb_add(&bar[XB_XSUB(b.x)], 1u);
        const unsigned gen = old / nloc;
        if (old + 1u == (gen + 1u) * nloc) {
            __builtin_amdgcn_fence(__ATOMIC_RELEASE, "agent");
            asm volatile("s_waitcnt vmcnt(0)" ::: "memory");
            const unsigned og = xb_add(&bar[XB_TOP], 1u);
            const unsigned tg = og / nx;
            if (og + 1u == (tg + 1u) * nx) xb_add(&bar[XB_TOPGEN], 1u);
            else XB_SPIN(xb_ld(&bar[XB_TOPGEN]) == tg, bar);
            __builtin_amdgcn_fence(__ATOMIC_ACQUIRE, "agent");
            xb_add(&bar[XB_XGEN(b.x)], 1u);
            asm volatile("s_waitcnt vmcnt(0)" ::: "memory");
        } else {
            XB_SPIN(xb_ld(&bar[XB_XGEN(b.x)]) == gen, bar);
            __builtin_amdgcn_fence(__ATOMIC_ACQUIRE, "agent");
            asm volatile("s_waitcnt vmcnt(0)" ::: "memory");
        }
    }
    __syncthreads();
}

struct Args { const void* in[24]; float* out; unsigned char* ws; int ph_lo, ph_hi; };
struct Frame {
    char* lds;
    int tid, lane, wave, G, bid;
    unsigned* ctl;
    const float *x, *p; const int* pos;
    const float *attn_g, *w_in, *q_g, *w_uq, *kv_g, *w_ukv, *conv_w, *w_out, *moe_g, *w_gr, *b_gr, *w_er, *b_er, *w_gate, *w_up, *w_down, *ple_g, *w_pg, *b_pg, *w_pp, *fin_g;
    float* out;
    bf16 *WinT, *WuqT, *WukvT, *WoutT, *WpgT, *WppT, *WguT, *WdT, *PB, *RA, *Z, *HBUF, *PROJ, *Q, *K, *V, *YBUF;
    float *RWT, *ROPE, *SSQ, *AW; int* LIST;
};

__device__ const double INVF[16] = {1.0, 0.5623413251903491, 0.31622776601683794, 0.1778279410038923, 0.1, 0.05623413251903491, 0.03162277660168379, 0.01778279410038923,
                                    0.01, 0.005623413251903491, 0.0031622776601683794, 0.0017782794100389228, 0.001, 0.0005623413251903491, 0.00031622776601683794, 0.00017782794100389227};

__device__ __forceinline__ void wt_item(const float* W, int ldw, const float* ksc, bf16* WT, int K, int k0, int n0, int srccol, float* scr, int lane) {
#pragma unroll 8
    for (int i = 0; i < 32; ++i) { const int kk = 2 * i + (lane >> 5);
        float v = 0.f; if (srccol >= 0) { v = W[(size_t)(k0 + kk) * ldw + srccol]; if (ksc) v *= ksc[k0 + kk]; }
        scr[kk * 33 + (lane & 31)] = v; }
    __builtin_amdgcn_s_waitcnt(0); asm volatile("" ::: "memory");
    const int c = lane & 7;
#pragma unroll
    for (int j = 0; j < 4; ++j) { const int n = (lane >> 3) + 8 * j; const float* s = scr + (8 * c) * 33 + n;
        u32x4 o; o.x = pk2(s[0 * 33], s[1 * 33]); o.y = pk2(s[2 * 33], s[3 * 33]); o.z = pk2(s[4 * 33], s[5 * 33]); o.w = pk2(s[6 * 33], s[7 * 33]);
        *(u32x4*)(WT + (size_t)(n0 + n) * K + k0 + 8 * c) = o; }
    __builtin_amdgcn_s_waitcnt(0); asm volatile("" ::: "memory");
}
__device__ __forceinline__ int uq_srccol(int n) {
    const int h = n / 96, p = n % 96; if (p < 64) return h * 96 + p;
    const int r = p - 64, g = r >> 3, j = r & 7, i = 4 * g + (j & 3); return h * 96 + 64 + ((j < 4) ? i : 16 + i);
}
__device__ __forceinline__ void rms_row_to_bf16(const float* xrow, const float* g, bf16* orow, int lane) {
    const f32x4* xr = (const f32x4*)xrow + lane; const f32x4* gr = (const f32x4*)g + lane;
    f32x4 v[4]; float s = 0.f;
#pragma unroll
    for (int j = 0; j < 4; ++j) { v[j] = xr[64 * j]; s += (v[j].x * v[j].x + v[j].y * v[j].y) + (v[j].z * v[j].z + v[j].w * v[j].w); }
    const float rinv = 1.f / sqrtf(wave_sum(s) * (1.f / D) + EPS);
    u32x2* o8 = (u32x2*)orow + lane;
#pragma unroll
    for (int j = 0; j < 4; ++j) { const f32x4 gg = gr[64 * j]; u32x2 o; o.x = pk2(v[j].x * rinv * gg.x, v[j].y * rinv * gg.y); o.y = pk2(v[j].z * rinv * gg.z, v[j].w * rinv * gg.w); o8[64 * j] = o; }
}
__device__ __forceinline__ void p0_prologue(Frame& F) {
    float* scr = (float*)(F.lds + F.wave * 16384);
    const int gw = F.bid * NWAVES + F.wave, NGW = F.G * NWAVES, lane = F.lane;
    constexpr int I_IN = (ZC / 32) * (D / 64), I_UQ = (768 / 32) * (QLORA / 64), I_UKV = (1024 / 32) * (KVLORA / 64), I_OUT = 32 * 16, I_PG = 32 * 16, I_PP = 32 * 4;
    constexpr int I_GU1 = 32 * 16, I_GU = NEXP * I_GU1, I_D1 = 32 * 8, I_DD = NEXP * I_D1;
    constexpr int NITEMS = I_IN + I_UQ + I_UKV + I_OUT + I_PG + I_PP + I_GU + I_DD;
    for (int it = gw; it < NITEMS; it += NGW) {
        int r = it;
        if (r < I_IN) { const int nb = r / 16, kb = r % 16, n = nb * 32 + (lane & 31); wt_item(F.w_in, ZN, nullptr, F.WinT, D, kb * 64, nb * 32, n < ZN ? n : -1, scr, lane); continue; } r -= I_IN;
        if (r < I_UQ) { const int nb = r / 6, kb = r % 6, n = nb * 32 + (lane & 31); wt_item(F.w_uq, 768, F.q_g, F.WuqT, QLORA, kb * 64, nb * 32, uq_srccol(n), scr, lane); continue; } r -= I_UQ;
        if (r < I_UKV) { const int nb = r / 4, kb = r % 4, n = nb * 32 + (lane & 31); wt_item(F.w_ukv, 1024, F.kv_g, F.WukvT, KVLORA, kb * 64, nb * 32, n, scr, lane); continue; } r -= I_UKV;
        if (r < I_OUT) { const int nb = r / 16, kb = r % 16, n = nb * 32 + (lane & 31); wt_item(F.w_out, D, nullptr, F.WoutT, D, kb * 64, nb * 32, n, scr, lane); continue; } r -= I_OUT;
        if (r < I_PG) { const int nb = r / 16, kb = r % 16, n = nb * 32 + (lane & 31); wt_item(F.w_pg, D, nullptr, F.WpgT, D, kb * 64, nb * 32, n, scr, lane); continue; } r -= I_PG;
        if (r < I_PP) { const int nb = r / 4, kb = r % 4, n = nb * 32 + (lane & 31); wt_item(F.w_pp, D, nullptr, F.WppT, PLE, kb * 64, nb * 32, n, scr, lane); continue; } r -= I_PP;
        if (r < I_GU) { const int e = r / I_GU1, q = r % I_GU1, nb = q / 16, kb = q % 16, n = nb * 32 + (lane & 31), t = n >> 8, w = n & 255;
            const float* W = ((w < 128) ? F.w_gate : F.w_up) + (size_t)e * D * FF;
            wt_item(W, FF, nullptr, F.WguT + (size_t)e * 1024 * 1024, D, kb * 64, nb * 32, 128 * t + (w & 127), scr, lane); continue; } r -= I_GU;
        { const int e = r / I_D1, q = r % I_D1, nb = q / 8, kb = q % 8, n = nb * 32 + (lane & 31);
            wt_item(F.w_down + (size_t)e * FF * D, D, nullptr, F.WdT + (size_t)e * 1024 * 512, FF, kb * 64, nb * 32, n, scr, lane); }
    }
    for (int m = gw; m < NTOK; m += NGW) rms_row_to_bf16(F.x + (size_t)m * D, F.attn_g, F.RA + (size_t)m * D, lane);
    { const int gt = F.bid * NTHREADS + F.tid, NGT = F.G * NTHREADS;
      for (int i = gt; i < NTOK * PLE / 8; i += NGT) { const f32x4 a = ((const f32x4*)F.p)[2 * i], b = ((const f32x4*)F.p)[2 * i + 1];
          u32x4 o; o.x = pk2(a.x, a.y); o.y = pk2(a.z, a.w); o.z = pk2(b.x, b.y); o.w = pk2(b.z, b.w); ((u32x4*)F.PB)[i] = o; }
      for (int i = gt; i < NTOK * 16; i += NGT) { const int m = i >> 4, f = i & 15;
          const float ang = (float)F.pos[m] * (float)INVF[f];
          double t = (double)ang * 0.15915494309189535; t -= __builtin_floor(t); if (t >= 0.5) t -= 1.0;
          const double xx = t * 6.283185307179586, x2 = xx * xx;
          double c = 1.0 / 620448401733239439360000.0, s = 1.0 / 15511210043330985984000000.0;
          c = c * -x2 + 1.0 / 1124000727777607680000.0;  s = s * -x2 + 1.0 / 25852016738884976640000.0;
          c = c * -x2 + 1.0 / 2432902008176640000.0;     s = s * -x2 + 1.0 / 51090942171709440000.0;
          c = c * -x2 + 1.0 / 6402373705728000.0;        s = s * -x2 + 1.0 / 121645100408832000.0;
          c = c * -x2 + 1.0 / 20922789888000.0;          s = s * -x2 + 1.0 / 355687428096000.0;
          c = c * -x2 + 1.0 / 87178291200.0;             s = s * -x2 + 1.0 / 1307674368000.0;
          c = c * -x2 + 1.0 / 479001600.0;               s = s * -x2 + 1.0 / 6227020800.0;
          c = c * -x2 + 1.0 / 3628800.0;                 s = s * -x2 + 1.0 / 39916800.0;
          c = c * -x2 + 1.0 / 40320.0;                   s = s * -x2 + 1.0 / 362880.0;
          c = c * -x2 + 1.0 / 720.0;                     s = s * -x2 + 1.0 / 5040.0;
          c = c * -x2 + 1.0 / 24.0;                      s = s * -x2 + 1.0 / 120.0;
          c = c * -x2 + 0.5;                             s = s * -x2 + 1.0 / 6.0;
          c = c * -x2 + 1.0;                             s = s * -x2 + 1.0;  s *= xx;
          F.ROPE[m * 32 + f] = (float)c; F.ROPE[m * 32 + 16 + f] = (float)s; }
      for (int i = gt; i < 36 * D; i += NGT) { const int j = i / D, k = i % D; F.RWT[i] = (j < 4) ? F.w_gr[k * 4 + j] : F.w_er[k * 32 + (j - 4)]; }
    }
}

template <bool DUAL, class Epi>
__device__ __forceinline__ void ngemm_tile(char* lds, const bf16* A, int lda, const int* gath, int gcount, const bf16* B, const bf16* B2, int ldb, int K, const Epi& epi) {
    float* As = (float*)lds; float* Bs = As + 32 * 132; float* Bs2 = Bs + 32 * 68;
    const int t = threadIdx.x, ty = t >> 3, tx = t & 7, lr = t >> 2, lc = (t & 3) * 8;
    float acc[2][8], acc2[2][8];
#pragma unroll
    for (int i = 0; i < 2; ++i)
#pragma unroll
        for (int j = 0; j < 8; ++j) { acc[i][j] = 0.f; acc2[i][j] = 0.f; }
    int srow = lr; if (gath) srow = (lr < gcount) ? (gath[lr] >> 1) : 0;
    const bf16* ap = A + (size_t)srow * lda + lc;
    const bf16* bp = B + (size_t)(lr & 63) * ldb + lc;
    const bf16* bp2 = DUAL ? (B2 + (size_t)(lr & 63) * ldb + lc) : bp;
    for (int k0 = 0; k0 < K; k0 += 32) {
        const u32x4 av = *(const u32x4*)(ap + k0);
        u32x4 bv = (u32x4){0, 0, 0, 0}, bv2 = (u32x4){0, 0, 0, 0};
        if (t < 256) { bv = *(const u32x4*)(bp + k0); if (DUAL) bv2 = *(const u32x4*)(bp2 + k0); }
        __syncthreads();
        { float v[8]; unpack8(av, v);
#pragma unroll
          for (int i = 0; i < 8; ++i) As[(lc + i) * 132 + lr] = v[i]; }
        if (t < 256) { float v[8]; unpack8(bv, v);
#pragma unroll
          for (int i = 0; i < 8; ++i) Bs[(lc + i) * 68 + lr] = v[i];
          if (DUAL) { unpack8(bv2, v);
#pragma unroll
            for (int i = 0; i < 8; ++i) Bs2[(lc + i) * 68 + lr] = v[i]; } }
        __syncthreads();
#pragma unroll 4
        for (int k = 0; k < 32; ++k) {
            const f32x2 a = *(const f32x2*)(As + k * 132 + 2 * ty);
            const f32x4 b0 = *(const f32x4*)(Bs + k * 68 + 8 * tx), b1 = *(const f32x4*)(Bs + k * 68 + 8 * tx + 4);
            const float bb[8] = {b0.x, b0.y, b0.z, b0.w, b1.x, b1.y, b1.z, b1.w};
#pragma unroll
            for (int j = 0; j < 8; ++j) { acc[0][j] = fmaf(a.x, bb[j], acc[0][j]); acc[1][j] = fmaf(a.y, bb[j], acc[1][j]); }
            if (DUAL) { const f32x4 c0 = *(const f32x4*)(Bs2 + k * 68 + 8 * tx), c1 = *(const f32x4*)(Bs2 + k * 68 + 8 * tx + 4);
                const float cc[8] = {c0.x, c0.y, c0.z, c0.w, c1.x, c1.y, c1.z, c1.w};
#pragma unroll
                for (int j = 0; j < 8; ++j) { acc2[0][j] = fmaf(a.x, cc[j], acc2[0][j]); acc2[1][j] = fmaf(a.y, cc[j], acc2[1][j]); } }
        }
    }
    __syncthreads();
    epi(2 * ty, 8 * tx, acc[0], acc2[0]); epi(2 * ty + 1, 8 * tx, acc[1], acc2[1]);
}
template <class EpiF>
__device__ __forceinline__ void ngemm_dense(Frame& F, const bf16* A, int lda, const bf16* B, int ldb, int M, int N, int K, const EpiF& epif) {
    const int ntn = N / 64, nt = (M / 128) * ntn;
    for (int it = F.bid; it < nt; it += F.G) { const int tm = it / ntn, tn = it % ntn;
        auto epi = [&](int r, int c, const float (&v)[8], const float (&v2)[8]) { epif(tm * 128 + r, tn * 64 + c, v); };
        ngemm_tile<false>(F.lds, A + (size_t)tm * 128 * lda, lda, nullptr, 0, B + (size_t)tn * 64 * ldb, nullptr, ldb, K, epi); }
}


namespace mm {
typedef short bf16x8 __attribute__((ext_vector_type(8)));
constexpr int BM = 256, BK = 64, HALF = 128, HTB = HALF * BK * 2, NXCD = 8, WGM = 8;
__host__ __device__ __forceinline__ int lds_byte(int r, int c) { const int st = (r >> 4) * 2 + (c >> 5), rr = r & 15, cc = c & 31, ob = rr * 64 + cc * 2; return st * 1024 + (ob ^ (((ob >> 9) & 1) << 5)); }
__host__ __device__ __forceinline__ void stage_rc(int b, int& R, int& C) { const int st = b / 1024, sb = b % 1024, swz = sb ^ (((sb >> 9) & 1) << 5); R = (st >> 1) * 16 + swz / 64; C = (st & 1) * 32 + (swz % 64) / 2; }
__host__ __device__ __forceinline__ int perm32(int rho) { const int n = rho >> 4, i = rho & 15; return 8 * (i >> 2) + 4 * n + (i & 3); }
struct Unit { int pm, pn, e, r0; };

struct DenseSched {
    const char* A; const char* B; int lda, ldb, nM, nN, nwg, G, c;
    __device__ __forceinline__ void init(const bf16* A_, int lda_, const bf16* B_, int ldb_, int M, int N, int G_, int c_) { A = (const char*)A_; B = (const char*)B_; lda = lda_; ldb = ldb_; nM = M / BM; nN = N / BM; nwg = nM * nN; G = G_; c = c_; }
    __device__ __forceinline__ bool next(int i, Unit& u) const {
        const long L = (long)i * G + c; if (L >= nwg) return false;
        int wgid = (int)L; { const int q = nwg / NXCD, r = nwg % NXCD, xcd = wgid % NXCD, off = wgid / NXCD; wgid = (xcd < r ? xcd * (q + 1) : r * (q + 1) + (xcd - r) * q) + off; }
        const int nig = WGM * nN, gid = wgid / nig, fm = gid * WGM, gsz = (nM - fm) < WGM ? (nM - fm) : WGM;
        u.pm = fm + ((wgid % nig) % gsz); u.pn = (wgid % nig) / gsz; u.e = 0; u.r0 = 0; return true;
    }
    __device__ __forceinline__ const char* a_base(const Unit& u) const { return A + (size_t)u.pm * BM * lda * 2; }
    __device__ __forceinline__ const char* b_base(const Unit& u) const { return B + (size_t)u.pn * BM * ldb * 2; }
    __device__ __forceinline__ unsigned a_goff(const Unit&, int) const { return 0u; }
};

template <class Epi, class Sched, bool ALIGN_EPI, bool GATHER>
__device__ __forceinline__ void mm_phase(LAS unsigned char* lds, const int K, const int lda, const int ldb, const Sched& S, const Epi& E) {
    const int tid = threadIdx.x, wid = __builtin_amdgcn_readfirstlane(tid >> 6), lane = tid & 63, wr = wid >> 2, wc = wid & 3, fr = lane & 15, fq = lane >> 4;
    const int nt = K / BK;
    unsigned voffA[2], voffB[2]; int RA_[2], CA_[2];
#pragma unroll
    for (int i = 0; i < 2; ++i) { int R, C; stage_rc(tid * 16 + i * 8192, R, C); const int Rb = Epi::PERM ? ((R & ~31) + perm32(R & 31)) : R;
        RA_[i] = R; CA_[i] = C; voffA[i] = (unsigned)(R * lda + C) * 2u; voffB[i] = (unsigned)(Rb * ldb + C) * 2u; }
    const size_t kstep = (size_t)(BK * 2);
    const size_t hstepA = GATHER ? 0 : (size_t)HALF * lda * 2, hstepB = (size_t)HALF * ldb * 2;
    const unsigned ldsw = (unsigned)wid * 1024u;
    const int aoff = lds_byte(wr * 64 + fr, fq * 8), boff = lds_byte(wc * 32 + fr, fq * 8);
#define MM_SA(b, h) (((b) * 2 + (h)) * HTB)
#define MM_SB(b, h) ((4 + (b) * 2 + (h)) * HTB)
#define MM_STAGE(bufoff, gbase, voff) do { _Pragma("unroll") for (int _i = 0; _i < 2; ++_i) \
        __builtin_amdgcn_global_load_lds((const unsigned*)((const char*)(gbase) + (voff)[_i]), (LAS unsigned*)(lds + (bufoff) + ldsw + _i * 8192), 16, 0, 0); } while (0)
#define MM_LDA(dst, b, h) do { _Pragma("unroll") for (int m = 0; m < 4; ++m) _Pragma("unroll") for (int k = 0; k < 2; ++k) dst[m][k] = *(const LAS bf16x8*)(lds + MM_SA(b, h) + aoff + m * 2048 + k * 1024); } while (0)
#define MM_LDB(dst, b, h) do { _Pragma("unroll") for (int n = 0; n < 2; ++n) _Pragma("unroll") for (int k = 0; k < 2; ++k) dst[n][k] = *(const LAS bf16x8*)(lds + MM_SB(b, h) + boff + n * 2048 + k * 1024); } while (0)
#define MM_MMA(ai, bj, At, Bt) do { __builtin_amdgcn_s_setprio(1); _Pragma("unroll") for (int m = 0; m < 4; ++m) _Pragma("unroll") for (int n = 0; n < 2; ++n) _Pragma("unroll") for (int k = 0; k < 2; ++k) \
        acc[ai][bj][m][n] = __builtin_amdgcn_mfma_f32_16x16x32_bf16(Bt[n][k], At[m][k], acc[ai][bj][m][n], 0, 0, 0); __builtin_amdgcn_s_setprio(0); } while (0)
#define MM_WAIT_V(n) asm volatile("s_waitcnt vmcnt(" #n ")" ::: "memory")
#define MM_WAIT_L(n) asm volatile("s_waitcnt lgkmcnt(" #n ")" ::: "memory")
#define MM_BAR __builtin_amdgcn_s_barrier()
#define MM_SCHED __builtin_amdgcn_sched_barrier(0)
    Unit cur, nxt; int ui = 0;
    if (!S.next(0, cur)) return;
    f32x4 acc[2][2][4][2];
#pragma unroll
    for (int a = 0; a < 2; ++a)
#pragma unroll
        for (int b = 0; b < 2; ++b)
#pragma unroll
            for (int m = 0; m < 4; ++m)
#pragma unroll
                for (int n = 0; n < 2; ++n) acc[a][b][m][n] = (f32x4){0.f, 0.f, 0.f, 0.f};
    bf16x8 At[4][2], B0[2][2], B1[2][2];
    const char* cA = S.a_base(cur); const char* cB = S.b_base(cur);
    unsigned cv0[2], cv1[2], nv0[2], nv1[2];
#pragma unroll
    for (int i = 0; i < 2; ++i) { if (GATHER) { cv0[i] = S.a_goff(cur, RA_[i]) + (unsigned)CA_[i] * 2u; cv1[i] = S.a_goff(cur, RA_[i] + HALF) + (unsigned)CA_[i] * 2u; } else { cv0[i] = voffA[i]; cv1[i] = voffA[i]; }
        nv0[i] = cv0[i]; nv1[i] = cv1[i]; }
    MM_STAGE(MM_SB(0, 0), cB, voffB); MM_STAGE(MM_SB(0, 1), cB + hstepB, voffB); MM_STAGE(MM_SA(0, 0), cA, cv0); MM_STAGE(MM_SA(0, 1), cA + hstepA, cv1);
    if (wr == 1) MM_BAR;
    MM_WAIT_V(2); MM_BAR;
    MM_STAGE(MM_SB(1, 0), cB + kstep, voffB); MM_STAGE(MM_SA(1, 0), cA + kstep, cv0); MM_STAGE(MM_SB(1, 1), cB + hstepB + kstep, voffB);
    MM_WAIT_V(6); MM_BAR;
    for (;;) {
        const bool has_next = S.next(ui + 1, nxt);
        const char* nA = has_next ? S.a_base(nxt) : cA; const char* nB = has_next ? S.b_base(nxt) : cB;
        if (GATHER) {
#pragma unroll
            for (int i = 0; i < 2; ++i) { if (has_next) { nv0[i] = S.a_goff(nxt, RA_[i]) + (unsigned)CA_[i] * 2u; nv1[i] = S.a_goff(nxt, RA_[i] + HALF) + (unsigned)CA_[i] * 2u; } else { nv0[i] = cv0[i]; nv1[i] = cv1[i]; } }
        }
#pragma unroll 1
        for (int t = 0; t < nt; t += 2) {
            const bool last = (t == nt - 2);
            const char* a1 = cA + (size_t)(t + 1) * kstep;
            const char* a2 = last ? nA : cA + (size_t)(t + 2) * kstep; const char* b2 = last ? nB : cB + (size_t)(t + 2) * kstep;
            const char* a3 = a2 + kstep; const char* b3 = b2 + kstep;
            unsigned x0[2], x1[2];
#pragma unroll
            for (int i = 0; i < 2; ++i) { x0[i] = (GATHER && last) ? nv0[i] : cv0[i]; x1[i] = (GATHER && last) ? nv1[i] : cv1[i]; }
            MM_LDB(B0, 0, 0); MM_LDB(B1, 0, 1); MM_SCHED; MM_LDA(At, 0, 0); MM_STAGE(MM_SA(1, 1), a1 + hstepA, cv1);
            MM_WAIT_V(8); MM_WAIT_L(0); MM_BAR; MM_MMA(0, 0, At, B0); MM_MMA(0, 1, At, B1); MM_BAR; MM_SCHED;
            MM_LDA(At, 0, 1); MM_STAGE(MM_SB(0, 0), b2, voffB); MM_STAGE(MM_SB(0, 1), b2 + hstepB, voffB); MM_STAGE(MM_SA(0, 0), a2, x0);
            MM_WAIT_V(8); MM_WAIT_L(0); MM_BAR; MM_MMA(1, 0, At, B0); MM_MMA(1, 1, At, B1); MM_BAR; MM_SCHED;
            MM_LDB(B0, 1, 0); MM_LDB(B1, 1, 1); MM_SCHED; MM_LDA(At, 1, 0); MM_STAGE(MM_SA(0, 1), a2 + hstepA, x1);
            MM_WAIT_V(8); MM_WAIT_L(0); MM_BAR; MM_MMA(0, 0, At, B0); MM_MMA(0, 1, At, B1); MM_BAR; MM_SCHED;
            MM_LDA(At, 1, 1); MM_STAGE(MM_SB(1, 0), b3, voffB); MM_STAGE(MM_SB(1, 1), b3 + hstepB, voffB); MM_STAGE(MM_SA(1, 0), a3, x0);
            MM_WAIT_V(8); MM_WAIT_L(0); MM_BAR; MM_MMA(1, 0, At, B0); MM_MMA(1, 1, At, B1); MM_BAR; MM_SCHED;
        }
        if constexpr (ALIGN_EPI) { if (wr == 0) MM_BAR; }
        E(acc, cur, wr, wc, fr, fq);
        if (!has_next) break;
#pragma unroll
        for (int a = 0; a < 2; ++a)
#pragma unroll
            for (int b = 0; b < 2; ++b)
#pragma unroll
                for (int m = 0; m < 4; ++m)
#pragma unroll
                    for (int n = 0; n < 2; ++n) acc[a][b][m][n] = (f32x4){0.f, 0.f, 0.f, 0.f};
        cur = nxt; cA = nA; cB = nB; ++ui;
#pragma unroll
        for (int i = 0; i < 2; ++i) { cv0[i] = nv0[i]; cv1[i] = nv1[i]; }
        if constexpr (ALIGN_EPI) { if (wr == 1) MM_BAR; }
    }
    MM_WAIT_V(0);
    if constexpr (!ALIGN_EPI) { if (wr == 0) MM_BAR; }
    MM_BAR;
#undef MM_SA
#undef MM_SB
#undef MM_STAGE
#undef MM_LDA
#undef MM_LDB
#undef MM_MMA
#undef MM_WAIT_V
#undef MM_WAIT_L
#undef MM_BAR
#undef MM_SCHED
}
template <class F8> struct Epi8 {
    static constexpr bool PERM = true; F8 f;
    __device__ __forceinline__ void operator()(const f32x4 (&acc)[2][2][4][2], const Unit& u, int wr, int wc, int fr, int fq) const {
#pragma unroll
        for (int ai = 0; ai < 2; ++ai)
#pragma unroll
            for (int m = 0; m < 4; ++m)
#pragma unroll
                for (int bj = 0; bj < 2; ++bj) { const f32x4 a = acc[ai][bj][m][0], b = acc[ai][bj][m][1]; const float v[8] = {a[0], a[1], a[2], a[3], b[0], b[1], b[2], b[3]};
                    f(u, ai * HALF + wr * 64 + m * 16 + fr, bj * HALF + wc * 32 + 8 * fq, v); }
    }
};
template <class F8> struct EpiGU {
    static constexpr bool PERM = true; F8 f;
    __device__ __forceinline__ void operator()(const f32x4 (&acc)[2][2][4][2], const Unit& u, int wr, int wc, int fr, int fq) const {
#pragma unroll
        for (int ai = 0; ai < 2; ++ai)
#pragma unroll
            for (int m = 0; m < 4; ++m) { const f32x4 a = acc[ai][0][m][0], b = acc[ai][0][m][1], c = acc[ai][1][m][0], d = acc[ai][1][m][1];
                const float g[8] = {a[0], a[1], a[2], a[3], b[0], b[1], b[2], b[3]}, uu[8] = {c[0], c[1], c[2], c[3], d[0], d[1], d[2], d[3]};
                f(u, ai * HALF + wr * 64 + m * 16 + fr, wc * 32 + 8 * fq, g, uu); }
    }
};
}

__device__ __forceinline__ float rinv_from_ssq(const float* ssq_row, int g0, int ng, float inv_n) {
    float s = 0.f;
    for (int g = 0; g < ng; ++g) s += ssq_row[g0 + g];
    return 1.f / sqrtf(s * inv_n + EPS);
}
__device__ __forceinline__ void p1_ssq_from_z(Frame& F) {
    const int gt = F.bid * NTHREADS + F.tid, NGT = F.G * NTHREADS;
    for (int i = gt; i < NTOK * 20; i += NGT) { const int m = i / 20, g = i % 20; const u32x4* zp = (const u32x4*)(F.Z + (size_t)m * ZC + 32 * g);
        float s = 0.f;
#pragma unroll
        for (int j = 0; j < 4; ++j) { float v[8]; unpack8(zp[j], v);
#pragma unroll
            for (int q = 0; q < 8; ++q) s += v[q] * v[q]; }
        F.SSQ[m * 32 + g] = s; }
}
__device__ __forceinline__ void p2_krope_conv(Frame& F) {
    const int gt = F.bid * NTHREADS + F.tid, NGT = F.G * NTHREADS;
    for (int i = gt; i < NTOK * 4; i += NGT) { const int m = i >> 2, g = i & 3, b = m / SEQ, s = m % SEQ;
        const bf16* kr = F.Z + (size_t)m * ZC + KR0; const float* rp = F.ROPE + m * 32;
        float o[8];
#pragma unroll
        for (int j = 0; j < 4; ++j) { const int ii = 4 * g + j; const float x1 = bf2f(kr[ii]), x2 = bf2f(kr[16 + ii]), c = rp[ii], sn = rp[16 + ii];
            o[j] = x1 * c - x2 * sn; o[4 + j] = x2 * c + x1 * sn; }
        const u32x4 w = pack8(o);
#pragma unroll
        for (int h = 0; h < NH; ++h) *(u32x4*)(F.K + ((size_t)(b * NH + h) * SEQ + s) * DQK + 64 + 8 * g) = w; }
    const int gw = F.bid * NWAVES + F.wave, NGW = F.G * NWAVES, lane = F.lane;
    float w0[8], w1[8], w2[8];
#pragma unroll
    for (int j = 0; j < 8; ++j) { w0[j] = F.conv_w[8 * lane + j]; w1[j] = F.conv_w[CONVW + 8 * lane + j]; w2[j] = F.conv_w[2 * CONVW + 8 * lane + j]; }
    for (int run = gw; run < NTOK / 16; run += NGW) { const int m0 = run * 16, s0 = m0 % SEQ;
        float cm2[8], cm1[8];
#pragma unroll
        for (int j = 0; j < 8; ++j) { cm2[j] = 0.f; cm1[j] = 0.f; }
        if (s0 >= 2) {
            float a[8], u[8];
            unpack8(*(const u32x4*)(F.Z + (size_t)(m0 - 2) * ZC + CG0 + 8 * lane), a); unpack8(*(const u32x4*)(F.Z + (size_t)(m0 - 2) * ZC + U0 + 8 * lane), u);
#pragma unroll
            for (int j = 0; j < 8; ++j) cm2[j] = a[j] * u[j];
            unpack8(*(const u32x4*)(F.Z + (size_t)(m0 - 1) * ZC + CG0 + 8 * lane), a); unpack8(*(const u32x4*)(F.Z + (size_t)(m0 - 1) * ZC + U0 + 8 * lane), u);
#pragma unroll
            for (int j = 0; j < 8; ++j) cm1[j] = a[j] * u[j];
        }
        for (int tt = 0; tt < 16; ++tt) { const int m = m0 + tt; const bf16* zr = F.Z + (size_t)m * ZC;
            float bg[8], cg[8], u[8], o[8];
            unpack8(*(const u32x4*)(zr + BG0 + 8 * lane), bg); unpack8(*(const u32x4*)(zr + CG0 + 8 * lane), cg); unpack8(*(const u32x4*)(zr + U0 + 8 * lane), u);
#pragma unroll
            for (int j = 0; j < 8; ++j) { const float cu = cg[j] * u[j]; o[j] = bg[j] * (w0[j] * cm2[j] + w1[j] * cm1[j] + w2[j] * cu); cm2[j] = cm1[j]; cm1[j] = cu; }
            *(u32x4*)(F.RA + (size_t)m * D + 512 + 8 * lane) = pack8(o); }
    }
}
__device__ __forceinline__ void p5_route(Frame& F) {
    int* lcnt = (int*)F.lds;
    int* gbase = lcnt + 32;
    int* sel = gbase + 32;
    const int lane = F.lane;
    for (int chunk = F.bid; chunk < NTOK / 128; chunk += F.G) {
        if (F.tid < 32) lcnt[F.tid] = 0;
        __syncthreads();
        for (int tt = 0; tt < 16; ++tt) { const int tl = F.wave * 16 + tt, m = chunk * 128 + tl;
            const f32x4* hr = (const f32x4*)(F.out + (size_t)m * D) + lane; const f32x4* gr = (const f32x4*)F.moe_g + lane;
            f32x4 v[4]; float s = 0.f;
#pragma unroll
            for (int j = 0; j < 4; ++j) { v[j] = hr[64 * j]; s += (v[j].x * v[j].x + v[j].y * v[j].y) + (v[j].z * v[j].z + v[j].w * v[j].w); }
            const float rinv = 1.f / sqrtf(wave_sum(s) * (1.f / D) + EPS);
            u32x2* o8 = (u32x2*)(F.RA + (size_t)m * D) + lane;
#pragma unroll
            for (int j = 0; j < 4; ++j) { const f32x4 gg = gr[64 * j]; v[j].x = v[j].x * rinv * gg.x; v[j].y = v[j].y * rinv * gg.y; v[j].z = v[j].z * rinv * gg.z; v[j].w = v[j].w * rinv * gg.w;
                u32x2 o; o.x = pk2(v[j].x, v[j].y); o.y = pk2(v[j].z, v[j].w); o8[64 * j] = o; }
            float lg[4];
#pragma unroll
            for (int i = 0; i < 4; ++i) { const f32x4* wr = (const f32x4*)(F.RWT + i * D) + lane; float a = 0.f;
#pragma unroll
                for (int j = 0; j < 4; ++j) { const f32x4 w = wr[64 * j]; a = fmaf(v[j].x, w.x, a); a = fmaf(v[j].y, w.y, a); a = fmaf(v[j].z, w.z, a); a = fmaf(v[j].w, w.w, a); }
                lg[i] = wave_sum(a) + F.b_gr[i]; }
            int gi = 0; float gm = lg[0];
#pragma unroll
            for (int i = 1; i < 4; ++i) if (lg[i] > gm) { gm = lg[i]; gi = i; }
            float gs = 0.f;
#pragma unroll
            for (int i = 0; i < 4; ++i) gs += __expf(lg[i] - gm);
            const float gp = 1.f / gs;
            gi = __builtin_amdgcn_readfirstlane(gi);
            float le[8];
#pragma unroll
            for (int i = 0; i < 8; ++i) { const f32x4* wr = (const f32x4*)(F.RWT + (4 + gi * 8 + i) * D) + lane; float a = 0.f;
#pragma unroll
                for (int j = 0; j < 4; ++j) { const f32x4 w = wr[64 * j]; a = fmaf(v[j].x, w.x, a); a = fmaf(v[j].y, w.y, a); a = fmaf(v[j].z, w.z, a); a = fmaf(v[j].w, w.w, a); }
                le[i] = wave_sum(a) + F.b_er[gi * 8 + i]; }
            int e0 = 0; float m0 = le[0];
#pragma unroll
            for (int i = 1; i < 8; ++i) if (le[i] > m0) { m0 = le[i]; e0 = i; }
            int e1 = -1; float m1 = -3.0e38f;
#pragma unroll
            for (int i = 0; i < 8; ++i) if (i != e0 && le[i] > m1) { m1 = le[i]; e1 = i; }
            const float p1 = __expf(m1 - m0), den = 1.f / (1.f + p1);
            if (lane == 0) {
                F.AW[2 * m] = gp * den; F.AW[2 * m + 1] = gp * p1 * den;
                const int E0 = gi * 8 + e0, E1 = gi * 8 + e1;
                const int q0 = atomicAdd(&lcnt[E0], 1), q1 = atomicAdd(&lcnt[E1], 1);
                sel[2 * tl] = (E0 << 16) | q0; sel[2 * tl + 1] = (E1 << 16) | q1;
            }
        }
        __syncthreads();
        if (F.tid < 32) gbase[F.tid] = (int)__hip_atomic_fetch_add(F.ctl + CW_CNT + F.tid, (unsigned)lcnt[F.tid], __ATOMIC_RELAXED, __HIP_MEMORY_SCOPE_AGENT);
        __syncthreads();
        if (F.tid < 256) { const int sv = sel[F.tid], e = sv >> 16, q = sv & 0xffff, m = chunk * 128 + (F.tid >> 1);
            F.LIST[e * LISTCAP + gbase[e] + q] = (m << 1) | (F.tid & 1); }
        __syncthreads();
    }
}
__device__ __forceinline__ void moe_tile_table(Frame& F, int* tb, int* cnts) {
    if (F.tid == 0) { int acc = 0; for (int e = 0; e < NEXP; ++e) { const int c = (int)__hip_atomic_load(F.ctl + CW_CNT + e, __ATOMIC_RELAXED, __HIP_MEMORY_SCOPE_AGENT); cnts[e] = c; tb[e] = acc; acc += (c + 255) >> 8; } tb[NEXP] = acc; }
    __syncthreads();
}
__device__ __forceinline__ void p8_combine(Frame& F) {
    const int gw = F.bid * NWAVES + F.wave, NGW = F.G * NWAVES, lane = F.lane;
    for (int m = gw; m < NTOK; m += NGW) {
        f32x4* hr = (f32x4*)(F.out + (size_t)m * D) + lane; const f32x4* gr = (const f32x4*)F.ple_g + lane;
        const u32x2* y0 = (const u32x2*)(F.YBUF + (size_t)(2 * m) * D) + lane; const u32x2* y1 = (const u32x2*)(F.YBUF + (size_t)(2 * m + 1) * D) + lane;
        f32x4 v[4]; float s = 0.f;
#pragma unroll
        for (int j = 0; j < 4; ++j) { v[j] = hr[64 * j]; const u32x2 a = y0[64 * j], b = y1[64 * j];
            v[j].x += bflo(a.x) + bflo(b.x); v[j].y += bfhi(a.x) + bfhi(b.x); v[j].z += bflo(a.y) + bflo(b.y); v[j].w += bfhi(a.y) + bfhi(b.y);
            hr[64 * j] = v[j]; s += (v[j].x * v[j].x + v[j].y * v[j].y) + (v[j].z * v[j].z + v[j].w * v[j].w); }
        const float rinv = 1.f / sqrtf(wave_sum(s) * (1.f / D) + EPS);
        u32x2* o8 = (u32x2*)(F.RA + (size_t)m * D) + lane;
#pragma unroll
        for (int j = 0; j < 4; ++j) { const f32x4 gg = gr[64 * j]; u32x2 o; o.x = pk2(v[j].x * rinv * gg.x, v[j].y * rinv * gg.y); o.y = pk2(v[j].z * rinv * gg.z, v[j].w * rinv * gg.w); o8[64 * j] = o; }
    }
}
__device__ __forceinline__ void p10_final(Frame& F) {
    const int gw = F.bid * NWAVES + F.wave, NGW = F.G * NWAVES, lane = F.lane;
    for (int m = gw; m < NTOK; m += NGW) {
        f32x4* hr = (f32x4*)(F.out + (size_t)m * D) + lane; const f32x4* gr = (const f32x4*)F.fin_g + lane;
        f32x4 v[4]; float s = 0.f;
#pragma unroll
        for (int j = 0; j < 4; ++j) { v[j] = hr[64 * j]; s += (v[j].x * v[j].x + v[j].y * v[j].y) + (v[j].z * v[j].z + v[j].w * v[j].w); }
        const float rinv = 1.f / sqrtf(wave_sum(s) * (1.f / D) + EPS);
#pragma unroll
        for (int j = 0; j < 4; ++j) { const f32x4 gg = gr[64 * j]; f32x4 o; o.x = v[j].x * rinv * gg.x; o.y = v[j].y * rinv * gg.y; o.z = v[j].z * rinv * gg.z; o.w = v[j].w * rinv * gg.w; hr[64 * j] = o; }
    }
}

__device__ __forceinline__ void epi_q(Frame& F, int row, int col, const float (&v)[8]) {
    const float rinv = rinv_from_ssq(F.SSQ + row * 32, 0, 12, 1.f / QLORA);
    const int h = col / 96, p = col % 96, b = row / SEQ, s = row % SEQ; float o[8];
    if (p < 64) {
#pragma unroll
        for (int j = 0; j < 8; ++j) o[j] = v[j] * rinv * QSCALE;
    } else { const int g = (p - 64) >> 3; const float* rp = F.ROPE + row * 32;
#pragma unroll
        for (int j = 0; j < 4; ++j) { const int ii = 4 * g + j; const float x1 = v[j] * rinv, x2 = v[4 + j] * rinv, c = rp[ii], sn = rp[16 + ii];
            o[j] = (x1 * c - x2 * sn) * QSCALE; o[4 + j] = (x2 * c + x1 * sn) * QSCALE; } }
    *(u32x4*)(F.Q + ((size_t)(b * NH + h) * SEQ + s) * DQK + p) = pack8(o);
}
__device__ __forceinline__ void epi_kv(Frame& F, int row, int col, const float (&v)[8]) {
    const float rinv = rinv_from_ssq(F.SSQ + row * 32, 12, 8, 1.f / KVLORA);
    const int h = col >> 7, d = col & 127, b = row / SEQ, s = row % SEQ; float o[8];
#pragma unroll
    for (int j = 0; j < 8; ++j) o[j] = v[j] * rinv;
    if (d < 64) *(u32x4*)(F.K + ((size_t)(b * NH + h) * SEQ + s) * DQK + d) = pack8(o);
    else        *(u32x4*)(F.V + ((size_t)(b * NH + h) * SEQ + s) * DV + (d - 64)) = pack8(o);
}

__device__ __forceinline__ void nattn_item(Frame& F, int bh, int qb) {
    const int q = qb * 512 + F.tid;
    const int qlast = __builtin_amdgcn_readfirstlane(qb * 512 + F.wave * 64 + 63);
    float qv[96], o[64];
    { const u32x4* qp = (const u32x4*)(F.Q + ((size_t)bh * SEQ + q) * DQK);
#pragma unroll
      for (int c = 0; c < 12; ++c) { float t[8]; unpack8(qp[c], t);
#pragma unroll
          for (int j = 0; j < 8; ++j) qv[8 * c + j] = t[j]; } }
#pragma unroll
    for (int d = 0; d < 64; ++d) o[d] = 0.f;
    float m = -1e30f, l = 0.f;
    const bf16* Kb = F.K + (size_t)bh * SEQ * DQK; const bf16* Vb = F.V + (size_t)bh * SEQ * DV;
    for (int j = 0; j <= qlast; ++j) {
        const u32x4* kp = (const u32x4*)(Kb + (size_t)j * DQK);
        float s = 0.f;
#pragma unroll
        for (int c = 0; c < 12; ++c) { float t[8]; unpack8(kp[c], t);
#pragma unroll
            for (int i = 0; i < 8; ++i) s = fmaf(qv[8 * c + i], t[i], s); }
        if (j <= q) {
            if (s > m) { const float cf = exp2f(m - s); l *= cf;
#pragma unroll
                for (int d = 0; d < 64; ++d) o[d] *= cf;
                m = s; }
            const float pj = exp2f(s - m); l += pj;
            const u32x4* vp = (const u32x4*)(Vb + (size_t)j * DV);
#pragma unroll
            for (int c = 0; c < 8; ++c) { float t[8]; unpack8(vp[c], t);
#pragma unroll
                for (int i = 0; i < 8; ++i) o[8 * c + i] = fmaf(pj, t[i], o[8 * c + i]); }
        }
    }
    const float il = 1.f / l; const int b = bh / NH, h = bh % NH;
    bf16* op = F.RA + ((size_t)b * SEQ + q) * D + h * DV;
#pragma unroll
    for (int c = 0; c < 8; ++c) { float t[8];
#pragma unroll
        for (int i = 0; i < 8; ++i) t[i] = o[8 * c + i] * il;
        *(u32x4*)(op + 8 * c) = pack8(t); }
}


struct EpiZ {
    static constexpr bool PERM = true; bf16* Z; float* SSQ;
    __device__ __forceinline__ void operator()(const f32x4 (&acc)[2][2][4][2], const mm::Unit& u, int wr, int wc, int fr, int fq) const {
#pragma unroll
        for (int bj = 0; bj < 2; ++bj) { const int G = u.pn * 8 + bj * 4 + wc, col = u.pn * 256 + bj * 128 + wc * 32 + 8 * fq;
#pragma unroll
            for (int ai = 0; ai < 2; ++ai)
#pragma unroll
                for (int m = 0; m < 4; ++m) { const int row = u.pm * 256 + ai * 128 + wr * 64 + m * 16 + fr; const f32x4 a = acc[ai][bj][m][0], b = acc[ai][bj][m][1];
                    u32x4 w; w.x = pkf(a[0], a[1]); w.y = pkf(a[2], a[3]); w.z = pkf(b[0], b[1]); w.w = pkf(b[2], b[3]);
                    *(u32x4*)(Z + (size_t)row * ZC + col) = w;
                    if (G < 20) { float s = (a[0] * a[0] + a[1] * a[1]) + (a[2] * a[2] + a[3] * a[3]) + (b[0] * b[0] + b[1] * b[1]) + (b[2] * b[2] + b[3] * b[3]);
                        s += __shfl_xor(s, 16); s += __shfl_xor(s, 32); if (fq == 0) SSQ[row * 32 + G] = s; } } }
    }
};

struct EpiQ {
    static constexpr bool PERM = true; const float* SSQ; const float* ROPE; bf16* Q;
    __device__ __forceinline__ void operator()(const f32x4 (&acc)[2][2][4][2], const mm::Unit& u, int wr, int wc, int fr, int fq) const {
#pragma unroll
        for (int ai = 0; ai < 2; ++ai)
#pragma unroll
            for (int m = 0; m < 4; ++m) { const int row = u.pm * 256 + ai * 128 + wr * 64 + m * 16 + fr, b = row / SEQ, sq = row % SEQ;
                const f32x4* sp = (const f32x4*)(SSQ + row * 32); const f32x4 s0 = sp[0], s1 = sp[1], s2 = sp[2];
                const float ss = ((s0[0] + s0[1]) + (s0[2] + s0[3])) + ((s1[0] + s1[1]) + (s1[2] + s1[3])) + ((s2[0] + s2[1]) + (s2[2] + s2[3]));
                const float rs = QSCALE / sqrtf(ss * (1.f / QLORA) + EPS);
#pragma unroll
                for (int bj = 0; bj < 2; ++bj) { const int col = u.pn * 256 + bj * 128 + wc * 32 + 8 * fq, h = col / 96, p = col - h * 96;
                    const f32x4 a = acc[ai][bj][m][0] * rs, c = acc[ai][bj][m][1] * rs; u32x4 w;
                    if (p < 64) { w.x = pkf(a[0], a[1]); w.y = pkf(a[2], a[3]); w.z = pkf(c[0], c[1]); w.w = pkf(c[2], c[3]); }
                    else { const int g = (p - 64) >> 3; const f32x4 cs = *(const f32x4*)(ROPE + row * 32 + 4 * g), sn = *(const f32x4*)(ROPE + row * 32 + 16 + 4 * g);
                        const f32x4 o1 = a * cs - c * sn, o2 = c * cs + a * sn;
                        w.x = pkf(o1[0], o1[1]); w.y = pkf(o1[2], o1[3]); w.z = pkf(o2[0], o2[1]); w.w = pkf(o2[2], o2[3]); }
                    *(u32x4*)(Q + ((size_t)(b * NH + h) * SEQ + sq) * DQK + p) = w; } }
    }
};
struct EpiKV {
    static constexpr bool PERM = true; const float* SSQ; bf16* K; bf16* V;
    __device__ __forceinline__ void operator()(const f32x4 (&acc)[2][2][4][2], const mm::Unit& u, int wr, int wc, int fr, int fq) const {
#pragma unroll
        for (int ai = 0; ai < 2; ++ai)
#pragma unroll
            for (int m = 0; m < 4; ++m) { const int row = u.pm * 256 + ai * 128 + wr * 64 + m * 16 + fr, b = row / SEQ, sq = row % SEQ;
                const f32x4* sp = (const f32x4*)(SSQ + row * 32 + 12); const f32x4 s0 = sp[0], s1 = sp[1];
                const float ss = ((s0[0] + s0[1]) + (s0[2] + s0[3])) + ((s1[0] + s1[1]) + (s1[2] + s1[3]));
                const float rs = 1.f / sqrtf(ss * (1.f / KVLORA) + EPS);
#pragma unroll
                for (int bj = 0; bj < 2; ++bj) { const int col = u.pn * 256 + bj * 128 + wc * 32 + 8 * fq, h = col >> 7, d = col & 127;
                    const f32x4 a = acc[ai][bj][m][0] * rs, c = acc[ai][bj][m][1] * rs; u32x4 w; w.x = pkf(a[0], a[1]); w.y = pkf(a[2], a[3]); w.z = pkf(c[0], c[1]); w.w = pkf(c[2], c[3]);
                    const size_t tk = (size_t)(b * NH + h) * SEQ + sq;
                    if (d < 64) *(u32x4*)(K + tk * DQK + d) = w; else *(u32x4*)(V + tk * DV + (d - 64)) = w; } }
    }
};
struct EpiBf {
    static constexpr bool PERM = true; bf16* O; int ldc;
    __device__ __forceinline__ void operator()(const f32x4 (&acc)[2][2][4][2], const mm::Unit& u, int wr, int wc, int fr, int fq) const {
#pragma unroll
        for (int ai = 0; ai < 2; ++ai)
#pragma unroll
            for (int m = 0; m < 4; ++m) { bf16* rp = O + (size_t)(u.pm * 256 + ai * 128 + wr * 64 + m * 16 + fr) * ldc + u.pn * 256 + wc * 32 + 8 * fq;
#pragma unroll
                for (int bj = 0; bj < 2; ++bj) { const f32x4 a = acc[ai][bj][m][0], c = acc[ai][bj][m][1]; u32x4 w; w.x = pkf(a[0], a[1]); w.y = pkf(a[2], a[3]); w.z = pkf(c[0], c[1]); w.w = pkf(c[2], c[3]);
                    *(u32x4*)(rp + bj * 128) = w; } }
    }
};

struct MoeSched {
    const char* A; const char* B; const int* LIST; const LAS int* tb; const LAS int* cnts; int lda, ldb, npn, G, c; size_t bstride; bool gather;
    __device__ __forceinline__ bool next(int i, mm::Unit& u) const {
        const int nwg = __builtin_amdgcn_readfirstlane(tb[NEXP]) * npn; const long L = (long)i * G + c; if (L >= nwg) return false;
        int wgid = (int)L; { const int q = nwg / 8, r = nwg % 8, xcd = wgid % 8, off = wgid / 8; wgid = (xcd < r ? xcd * (q + 1) : r * (q + 1) + (xcd - r) * q) + off; }
        const int R = wgid / npn; int e = 0; while (tb[e + 1] <= R) ++e;
        u.pm = __builtin_amdgcn_readfirstlane(R); u.pn = __builtin_amdgcn_readfirstlane(wgid - R * npn); u.e = __builtin_amdgcn_readfirstlane(e); u.r0 = __builtin_amdgcn_readfirstlane((R - tb[e]) * 256); return true;
    }
    __device__ __forceinline__ const char* a_base(const mm::Unit& u) const { return gather ? A : A + (size_t)u.pm * 256 * lda * 2; }
    __device__ __forceinline__ const char* b_base(const mm::Unit& u) const { return B + (size_t)u.e * bstride + (size_t)u.pn * 256 * ldb * 2; }
    __device__ __forceinline__ unsigned a_goff(const mm::Unit& u, int r) const { const int pos = u.r0 + r; int idx = 0; if (pos < cnts[u.e]) idx = LIST[u.e * LISTCAP + pos] >> 1; return (unsigned)idx * (unsigned)(lda * 2); }
};
struct EpiGate {
    static constexpr bool PERM = true; bf16* H;
    __device__ __forceinline__ void operator()(const f32x4 (&acc)[2][2][4][2], const mm::Unit& u, int wr, int wc, int fr, int fq) const {
#pragma unroll
        for (int ai = 0; ai < 2; ++ai)
#pragma unroll
            for (int m = 0; m < 4; ++m) { const f32x4 g0 = acc[ai][0][m][0], g1 = acc[ai][0][m][1], u0 = acc[ai][1][m][0], u1 = acc[ai][1][m][1]; f32x4 h0, h1;
#pragma unroll
                for (int j = 0; j < 4; ++j) { h0[j] = g0[j] / (1.f + __expf(-g0[j])) * u0[j]; h1[j] = g1[j] / (1.f + __expf(-g1[j])) * u1[j]; }
                u32x4 w; w.x = pkf(h0[0], h0[1]); w.y = pkf(h0[2], h0[3]); w.z = pkf(h1[0], h1[1]); w.w = pkf(h1[2], h1[3]);
                *(u32x4*)(H + (size_t)(u.pm * 256 + ai * 128 + wr * 64 + m * 16 + fr) * FF + u.pn * 128 + wc * 32 + 8 * fq) = w; }
    }
};
struct EpiDown {
    static constexpr bool PERM = true; bf16* Y; const float* AW; const int* LIST; const LAS int* cnts;
    __device__ __forceinline__ void operator()(const f32x4 (&acc)[2][2][4][2], const mm::Unit& u, int wr, int wc, int fr, int fq) const {
        const int cnt = cnts[u.e];
#pragma unroll
        for (int ai = 0; ai < 2; ++ai)
#pragma unroll
            for (int m = 0; m < 4; ++m) { const int pos = u.r0 + ai * 128 + wr * 64 + m * 16 + fr;
                if (pos < cnt) { const int a = LIST[u.e * LISTCAP + pos]; const float w_ = AW[a]; bf16* rp = Y + (size_t)a * D + u.pn * 256 + wc * 32 + 8 * fq;
#pragma unroll
                    for (int bj = 0; bj < 2; ++bj) { const f32x4 x = acc[ai][bj][m][0] * w_, y = acc[ai][bj][m][1] * w_; u32x4 w; w.x = pkf(x[0], x[1]); w.y = pkf(x[2], x[3]); w.z = pkf(y[0], y[1]); w.w = pkf(y[2], y[3]);
                        *(u32x4*)(rp + bj * 128) = w; } } }
    }
};
struct EpiH1 {
    static constexpr bool PERM = false; const float* x; float* out;
    __device__ __forceinline__ void operator()(const f32x4 (&acc)[2][2][4][2], const mm::Unit& u, int wr, int wc, int fr, int fq) const {
#pragma unroll
        for (int ai = 0; ai < 2; ++ai)
#pragma unroll
            for (int m = 0; m < 4; ++m) { const size_t ro = (size_t)(u.pm * 256 + ai * 128 + wr * 64 + m * 16 + fr) * D + u.pn * 256 + wc * 32 + 4 * fq;
#pragma unroll
                for (int bj = 0; bj < 2; ++bj)
#pragma unroll
                    for (int n = 0; n < 2; ++n) { const size_t o = ro + bj * 128 + n * 16; *(f32x4*)(out + o) = *(const f32x4*)(x + o) + acc[ai][bj][m][n]; } }
    }
};
struct EpiPle {
    static constexpr bool PERM = false; float* out; const bf16* proj; const float* bias;
    __device__ __forceinline__ void operator()(const f32x4 (&acc)[2][2][4][2], const mm::Unit& u, int wr, int wc, int fr, int fq) const {
        const int col0 = u.pn * 256 + wc * 32 + 4 * fq;
        f32x4 bv[2][2];
#pragma unroll
        for (int bj = 0; bj < 2; ++bj)
#pragma unroll
            for (int n = 0; n < 2; ++n) bv[bj][n] = *(const f32x4*)(bias + col0 + bj * 128 + n * 16);
#pragma unroll
        for (int ai = 0; ai < 2; ++ai)
#pragma unroll
            for (int m = 0; m < 4; ++m) { const size_t ro = (size_t)(u.pm * 256 + ai * 128 + wr * 64 + m * 16 + fr) * D + col0;
#pragma unroll
                for (int bj = 0; bj < 2; ++bj)
#pragma unroll
                    for (int n = 0; n < 2; ++n) { const size_t o = ro + bj * 128 + n * 16; const u32x2 pw = *(const u32x2*)(proj + o); const f32x4 h = *(const f32x4*)(out + o), g = acc[ai][bj][m][n] + bv[bj][n];
                        f32x4 r; r[0] = h[0] + bflo(pw.x) / (1.f + __expf(-g[0])); r[1] = h[1] + bfhi(pw.x) / (1.f + __expf(-g[1])); r[2] = h[2] + bflo(pw.y) / (1.f + __expf(-g[2])); r[3] = h[3] + bfhi(pw.y) / (1.f + __expf(-g[3]));
                        *(f32x4*)(out + o) = r; } }
    }
};

#ifndef ATTN_STORE16
#define ATTN_STORE16(p,v) (*(u32x4*)(p)=(v))
#endif
namespace attn96 {
using bf16=__hip_bfloat16;
using bf16x8=__attribute__((ext_vector_type(8)))short;
using s16x4=__attribute__((ext_vector_type(4)))short;
using f32x16=__attribute__((ext_vector_type(16)))float;
using u32x4=__attribute__((ext_vector_type(4)))unsigned;
constexpr int BATCH=4,NHEAD=8,SEQ=8192,DQ=96,DVH=64,OP=1024;
constexpr int NW=8,QBLK=32,QB=QBLK*NW,KVBLK=64,NQB=SEQ/QB;
__device__ __forceinline__ int crow(int r,int hi){return (r&3)+8*(r>>2)+4*hi;}
#define SBAR() __builtin_amdgcn_sched_barrier(0)
__device__ __forceinline__ void cmask(f32x16&p0,f32x16&p1,int jb,int qrel,int hi){
  const float NEG=-INFINITY; const int qd=qrel-64*jb-4*hi;
  #pragma unroll
  for(int r=0;r<16;++r){const int c=(r&3)+8*(r>>2); if(c>qd)p0[r]=NEG; if(c+32>qd)p1[r]=NEG;}
}

constexpr int NSLOT=3, SLOTB=8192, KSLOTB=12288;
constexpr int LDS_K=0, LDS_V=NSLOT*KSLOTB, LDS_WS=LDS_V+NSLOT*SLOTB, LDS_OST=LDS_WS+NW*64*4, LDS_BYTES=LDS_OST+NW*4096;
__device__ __forceinline__ void glds16(const void*gsrc,unsigned lds_dst){unsigned keep;
  asm volatile("s_mov_b32 %0, m0\n\ts_mov_b32 m0, %2\n\ts_nop 0\n\tglobal_load_lds_dwordx4 %1, off\n\ts_mov_b32 m0, %0":"=&s"(keep):"v"(gsrc),"s"(lds_dst):"memory");}
__device__ __forceinline__ void glds16s(const void*sbase,unsigned voff,unsigned lds_dst){unsigned keep;
  asm volatile("s_mov_b32 %0, m0\n\ts_mov_b32 m0, %3\n\ts_nop 4\n\tglobal_load_lds_dwordx4 %1, %2\n\ts_mov_b32 m0, %0":"=&s"(keep):"v"(voff),"s"(sbase),"s"(lds_dst):"memory");}
__device__ __forceinline__ float max3f(float a,float b,float c){float r;asm("v_max3_f32 %0, %1, %2, %3":"=v"(r):"v"(a),"v"(b),"v"(c));return r;}
__device__ __forceinline__ float max2f(float a,float b){float r;asm("v_max_f32_e32 %0, %1, %2":"=v"(r):"v"(a),"v"(b));return r;}
__device__ __forceinline__ float fadd_s(float a,float b){float r;asm("v_add_f32_e32 %0, %1, %2":"=v"(r):"v"(a),"v"(b));return r;}
__device__ __forceinline__ float fsub_s(float a,float b){float r;asm("v_sub_f32_e32 %0, %1, %2":"=v"(r):"v"(a),"v"(b));return r;}
typedef float f32x2_t __attribute__((ext_vector_type(2))); typedef __bf16 bf16x2_t __attribute__((ext_vector_type(2)));
__device__ __forceinline__ unsigned cvtpk_s(float lo,float hi){f32x2_t v={lo,hi};bf16x2_t b=__builtin_convertvector(v,bf16x2_t);return __builtin_bit_cast(unsigned,b);}
#define WAIT_BAR(N) asm volatile("s_waitcnt vmcnt(" #N ") lgkmcnt(0)\n\ts_barrier":::"memory")

__device__ __forceinline__ void qkt(f32x16&p0,f32x16&p1,const char*Kslot,const bf16x8*qr,const f32x16&negm,int r32,int hi){
  const char*kb=Kslot+hi*1024+r32*16;
  #pragma unroll
  for(int d0=0;d0<6;++d0){
    const bf16x8 b0=*reinterpret_cast<const bf16x8*>(kb+d0*2048);
    const bf16x8 b1=*reinterpret_cast<const bf16x8*>(kb+d0*2048+512);
    if(d0==0){p0=__builtin_amdgcn_mfma_f32_32x32x16_bf16(b0,qr[0],negm,0,0,0);p1=__builtin_amdgcn_mfma_f32_32x32x16_bf16(b1,qr[0],negm,0,0,0);}
    else{p0=__builtin_amdgcn_mfma_f32_32x32x16_bf16(b0,qr[d0],p0,0,0,0);p1=__builtin_amdgcn_mfma_f32_32x32x16_bf16(b1,qr[d0],p1,0,0,0);}}
}
typedef __attribute__((address_space(3))) const char* lds_cptr;
typedef short v4i16_t __attribute__((ext_vector_type(4)));
__device__ __forceinline__ void kload12(bf16x8*kf,lds_cptr kp){
  kf[0]=*(const __attribute__((address_space(3))) bf16x8*)(kp);      kf[1]=*(const __attribute__((address_space(3))) bf16x8*)(kp+512);
  kf[2]=*(const __attribute__((address_space(3))) bf16x8*)(kp+2048); kf[3]=*(const __attribute__((address_space(3))) bf16x8*)(kp+2560);
  kf[4]=*(const __attribute__((address_space(3))) bf16x8*)(kp+4096); kf[5]=*(const __attribute__((address_space(3))) bf16x8*)(kp+4608);
  kf[6]=*(const __attribute__((address_space(3))) bf16x8*)(kp+6144); kf[7]=*(const __attribute__((address_space(3))) bf16x8*)(kp+6656);
  kf[8]=*(const __attribute__((address_space(3))) bf16x8*)(kp+8192); kf[9]=*(const __attribute__((address_space(3))) bf16x8*)(kp+8704);
  kf[10]=*(const __attribute__((address_space(3))) bf16x8*)(kp+10240); kf[11]=*(const __attribute__((address_space(3))) bf16x8*)(kp+10752);
}
__device__ __forceinline__ void kload2(bf16x8*kf,lds_cptr kp,int j){ kf[2*j]=*(const __attribute__((address_space(3))) bf16x8*)(kp+j*2048); kf[2*j+1]=*(const __attribute__((address_space(3))) bf16x8*)(kp+j*2048+512); }
__device__ __forceinline__ s16x4 vtr(lds_cptr p){ return __builtin_bit_cast(s16x4,__builtin_amdgcn_ds_read_tr16_b64_v4i16((__attribute__((address_space(3))) v4i16_t*)p)); }
__device__ __forceinline__ float rowmax(const f32x16&p0,const f32x16&p1){
  float a=max3f(p0[0],p0[1],p1[0]),b=max3f(p0[2],p0[3],p1[1]);a=max3f(a,p1[2],p1[3]);
  #pragma unroll
  for(int r=4;r<16;r+=4){a=max3f(a,p0[r],p0[r+1]);b=max3f(b,p0[r+2],p0[r+3]);a=max3f(a,p1[r],p1[r+1]);b=max3f(b,p1[r+2],p1[r+3]);}
  const float m=max2f(a,b);
  auto rr=__builtin_amdgcn_permlane32_swap(__float_as_uint(m),__float_as_uint(m),false,false);
  return max2f(__uint_as_float(rr[0]),__uint_as_float(rr[1]));
}
__device__ __forceinline__ void pv(f32x16*o,int vb,bf16x8 pa0,bf16x8 pa1,bf16x8 pa2,bf16x8 pa3){
  #pragma unroll
  for(int d0=0;d0<2;++d0){s16x4 lo[4],hi[4];
    #pragma unroll
    for(int ks=0;ks<4;++ks){
      asm volatile("ds_read_b64_tr_b16 %0,%1 offset:%c2":"=&v"(lo[ks]):"v"(vb),"i"(d0*4096+ks*1024):"memory");
      asm volatile("ds_read_b64_tr_b16 %0,%1 offset:%c2":"=&v"(hi[ks]):"v"(vb),"i"(d0*4096+ks*1024+512):"memory");}
    asm volatile("s_waitcnt lgkmcnt(0)":::"memory");SBAR();
    #define PK(k) (bf16x8){lo[k][0],lo[k][1],lo[k][2],lo[k][3],hi[k][0],hi[k][1],hi[k][2],hi[k][3]}
    o[d0]=__builtin_amdgcn_mfma_f32_32x32x16_bf16(pa0,PK(0),o[d0],0,0,0);
    o[d0]=__builtin_amdgcn_mfma_f32_32x32x16_bf16(pa1,PK(1),o[d0],0,0,0);
    o[d0]=__builtin_amdgcn_mfma_f32_32x32x16_bf16(pa2,PK(2),o[d0],0,0,0);
    o[d0]=__builtin_amdgcn_mfma_f32_32x32x16_bf16(pa3,PK(3),o[d0],0,0,0);
    #undef PK
  }
}

#ifndef ATTN_STORE16
#define ATTN_STORE16(p,v) (*(u32x4*)(p)=(v))
#endif
template<int THRL> __device__ __forceinline__ void attn_unit(int bh,int qb,const bf16*Q,const bf16*__restrict__ K,const bf16*__restrict__ V,bf16*O,char*shm){
  const int tid=threadIdx.x,lane=tid&63,r32=lane&31,hi=lane>>5; const int wid=__builtin_amdgcn_readfirstlane(tid>>6);
  const long rowbase=(long)bh*SEQ; const int q0=qb*QB; const int b=bh/NHEAD,h=bh%NHEAD;
  const bf16*Qw=Q+(rowbase+q0+wid*QBLK)*DQ;
  const bf16*Kh=K+rowbase*DQ,*Vh=V+rowbase*DVH;
  const unsigned lds0=(unsigned)(uintptr_t)shm;
  float*wsf=(float*)(shm+LDS_WS)+wid*64;
  const unsigned kvo=(unsigned)(lane*DQ+wid*8)*2u; const int k2d=(8+(wid&3)-wid)*16;
  const unsigned vvo=(unsigned)((16*(wid&3)+(lane>>2))*DVH+(wid>>2)*32+(lane&3)*8)*2u;
  const unsigned kdst=lds0+LDS_K+wid*1024, kdst2=lds0+LDS_K+(8+(wid&3))*1024, vdst=lds0+LDS_V+wid*1024;
  #define KOFF(s) ((s)+((s)>>1))
  #define DMA_K(t,slot) do{ const char*kb_=(const char*)Kh+(long)(t)*(KVBLK*DQ*2); glds16s(kb_,kvo,(unsigned)__builtin_amdgcn_readfirstlane(kdst+KOFF(slot))); glds16s(kb_+k2d,kvo,(unsigned)__builtin_amdgcn_readfirstlane(kdst2+KOFF(slot))); }while(0)
  #define DMA_V(t,slot) glds16s((const char*)Vh+(long)(t)*(KVBLK*DVH*2),vvo,(unsigned)__builtin_amdgcn_readfirstlane(vdst+(slot)))
  const int vb0=(int)(lds0+LDS_V)+((lane>>4)&1)*32+(lane&3)*8+(4*hi+((lane&15)>>2))*64;
  const char*Kbase=shm+LDS_K; bf16x8 kf[12];
  const lds_cptr shm3=(lds_cptr)shm; const lds_cptr kp0=shm3+LDS_K+hi*1024+r32*16; const lds_cptr vp0=shm3+LDS_V+((lane>>4)&1)*32+(lane&3)*8+(4*hi+((lane&15)>>2))*64;
  const int NT=(q0+QB)/KVBLK;
  DMA_K(0,0);DMA_V(0,0);DMA_K(1,SLOTB);
  bf16x8 qr[6];
  #pragma unroll
  for(int d0=0;d0<6;++d0)qr[d0]=*reinterpret_cast<const bf16x8*>(&Qw[(long)r32*DQ+d0*16+hi*8]);
  float mhat=0.f,l_reg=0.f;f32x16 o[2];o[0]=f32x16{};o[1]=f32x16{};
  const int qrel=wid*QBLK+r32;
  #define CMASK(P0,P1,t) do{int jb_=(t)-(NT-4); if(jb_>=0)cmask(P0,P1,jb_,qrel,hi);}while(0)
  bool resc=false;
  #define START(P0,P1) do{ const float rm=rowmax(P0,P1); resc=false; \
    { const float dl=rm; mhat=fadd_s(mhat,dl); \
      _Pragma("unroll") for(int r=0;r<16;++r){P0[r]=fsub_s(P0[r],dl);P1[r]=fsub_s(P1[r],dl);} \
      } \
    _Pragma("unroll") for(int r=0;r<16;++r)P0[r]=__builtin_amdgcn_exp2f(P0[r]); }while(0)
  #define RESC() do{ if(resc){ asm volatile("s_waitcnt lgkmcnt(0)":::"memory"); \
      _Pragma("unroll") for(int d_=0;d_<2;++d_) _Pragma("unroll") for(int r=0;r<16;++r)o[d_][r]*=wsf[crow(r,hi)]; } }while(0)
  f32x16 pA0,pA1,pB0,pB1;
  int sl_prev=0,sl_cur=0,sl_next=SLOTB;
  #define ROT() do{sl_prev=sl_cur;sl_cur=sl_next;sl_next=(sl_next==(NSLOT-1)*SLOTB)?0:sl_next+SLOTB;}while(0)
  DMA_K(2,2*SLOTB);
  WAIT_BAR(5);
  qkt(pA0,pA1,Kbase,qr,f32x16{},r32,hi);asm volatile("s_nop 15\n\ts_nop 7":"+v"(pA0),"+v"(pA1));CMASK(pA0,pA1,0);
  START(pA0,pA1);
  _Pragma("unroll") for(int r=0;r<16;++r)pA1[r]=__builtin_amdgcn_exp2f(pA1[r]);
  WAIT_BAR(0);
  DMA_K(3,0);DMA_V(1,SLOTB);
  ROT();
  kload12(kf,kp0+KOFF(sl_cur));
  WAIT_BAR(3);
  s16x4 vlo[8],vhi[8]; u32x4 pw0,pw1,pw2,pw3;
  #define PKW(P,B) cvtpk_s(P[B],P[B+1])
  #define PAF(k) __builtin_bit_cast(bf16x8,pw##k)
  #define VFR(i) (bf16x8){vlo[i][0],vlo[i][1],vlo[i][2],vlo[i][3],vhi[i][0],vhi[i][1],vhi[i][2],vhi[i][3]}
  #define PIN(x) asm volatile("":"+v"(x))
  #define MX3(a,b,c) __builtin_fmaxf(__builtin_fmaxf((a),(b)),(c))
  #define GAPA(MF,A0,A1,A2,A3,W0,W1,PW) do{ MF; sacc+=A0; sacc+=A1; sacc+=A2; sacc+=A3; PIN(sacc); W0; W1; PIN(PW); SBAR(); }while(0)
  #define EX(v) __builtin_amdgcn_exp2f(v)
  #define GAPB(MF,X,B) do{ MF; X[B]=EX(X[B]); X[B+1]=EX(X[B+1]); X[B+2]=EX(X[B+2]); X[B+3]=EX(X[B+3]); PIN(X); SBAR(); }while(0)
  #define VRD(i) do{ vlo[i]=vtr(vp_+(((i)>>2)*4096+((i)&3)*1024)); vhi[i]=vtr(vp_+(((i)>>2)*4096+((i)&3)*1024+512)); }while(0)
  #define KRD(G,j) do{ if(G){ kload2(kf,kp0+KOFF(sl_next),j); SBAR(); } }while(0)
  #define STEP(C0,C1,P0,P1,t,GK,GV,GL) do{ SBAR(); \
    const lds_cptr vp_=vp0+sl_prev; \
    VRD(0); SBAR(); float sacc=(P0[0]+P0[1]); \
    GAPA(C0=__builtin_amdgcn_mfma_f32_32x32x16_bf16(kf[0],qr[0],f32x16{},0,0,0), P0[2],P0[3],P0[4],P0[5],     pw0[0]=PKW(P0,0), pw0[1]=PKW(P0,2), pw0); \
    VRD(4); SBAR(); GAPA(C1=__builtin_amdgcn_mfma_f32_32x32x16_bf16(kf[1],qr[0],f32x16{},0,0,0), P0[6],P0[7],P0[8],P0[9],     pw0[2]=PKW(P0,4), pw0[3]=PKW(P0,6), pw0); \
    VRD(1); SBAR(); GAPA(C0=__builtin_amdgcn_mfma_f32_32x32x16_bf16(kf[2],qr[1],C0,0,0,0),   P0[10],P0[11],P0[12],P0[13], pw1[0]=PKW(P0,8), pw1[1]=PKW(P0,10), pw1); \
    VRD(5); SBAR(); GAPA(C1=__builtin_amdgcn_mfma_f32_32x32x16_bf16(kf[3],qr[1],C1,0,0,0),   P0[14],P0[15],P1[0],P1[1],   pw1[2]=PKW(P0,12),pw1[3]=PKW(P0,14), pw1); \
    VRD(2); SBAR(); GAPA(C0=__builtin_amdgcn_mfma_f32_32x32x16_bf16(kf[4],qr[2],C0,0,0,0),   P1[2],P1[3],P1[4],P1[5],     pw2[0]=PKW(P1,0), pw2[1]=PKW(P1,2), pw2); \
    VRD(6); SBAR(); GAPA(C1=__builtin_amdgcn_mfma_f32_32x32x16_bf16(kf[5],qr[2],C1,0,0,0),   P1[6],P1[7],P1[8],P1[9],     pw2[2]=PKW(P1,4), pw2[3]=PKW(P1,6), pw2); \
    VRD(3); SBAR(); GAPA(C0=__builtin_amdgcn_mfma_f32_32x32x16_bf16(kf[6],qr[3],C0,0,0,0),   P1[10],P1[11],P1[12],P1[13], pw3[0]=PKW(P1,8), pw3[1]=PKW(P1,10), pw3); \
    VRD(7); SBAR(); GAPA(C1=__builtin_amdgcn_mfma_f32_32x32x16_bf16(kf[7],qr[3],C1,0,0,0),   P1[14],P1[15],0.f,0.f,       pw3[2]=PKW(P1,12),pw3[3]=PKW(P1,14), pw3); \
    C0=__builtin_amdgcn_mfma_f32_32x32x16_bf16(kf[8],qr[4],C0,0,0,0); SBAR(); C1=__builtin_amdgcn_mfma_f32_32x32x16_bf16(kf[9],qr[4],C1,0,0,0); SBAR(); \
    C0=__builtin_amdgcn_mfma_f32_32x32x16_bf16(kf[10],qr[5],C0,0,0,0); SBAR(); C1=__builtin_amdgcn_mfma_f32_32x32x16_bf16(kf[11],qr[5],C1,0,0,0); SBAR(); \
    l_reg+=sacc; \
    if(GK){DMA_K((t)+3,sl_cur);} if(GV){DMA_V((t)+1,sl_next);} \
    _Pragma("unroll") for(int r=0;r<16;++r){C0[r]-=mhat;C1[r]-=mhat;} \
    CMASK(C0,C1,t); \
    { float a=MX3(C0[0],C0[1],C1[0]),b=MX3(C0[2],C0[3],C1[1]); a=MX3(a,C1[2],C1[3]); \
      _Pragma("unroll") for(int r=4;r<16;r+=4){a=MX3(a,C0[r],C0[r+1]);b=MX3(b,C0[r+2],C0[r+3]);a=MX3(a,C1[r],C1[r+1]);b=MX3(b,C1[r+2],C1[r+3]);} \
      float rm=__builtin_fmaxf(a,b); { auto rr=__builtin_amdgcn_permlane32_swap(__float_as_uint(rm),__float_as_uint(rm),false,false); rm=__builtin_fmaxf(__uint_as_float(rr[0]),__uint_as_float(rr[1])); } \
      resc=false; \
      if(__builtin_expect(__any(rm>(float)THRL),0)){ const float dl=__builtin_fmaxf(rm,0.f); mhat+=dl; \
        _Pragma("unroll") for(int r=0;r<16;++r){C0[r]-=dl;C1[r]-=dl;} \
        const float f=__builtin_amdgcn_exp2f(-dl); l_reg*=f; if(hi==0)wsf[r32]=f; resc=true; } } \
    SBAR(); \
    GAPB(o[0]=__builtin_amdgcn_mfma_f32_32x32x16_bf16(PAF(0),VFR(0),o[0],0,0,0), C0,0); \
    GAPB(o[1]=__builtin_amdgcn_mfma_f32_32x32x16_bf16(PAF(0),VFR(4),o[1],0,0,0), C0,4); \
    KRD(GL,0); GAPB(o[0]=__builtin_amdgcn_mfma_f32_32x32x16_bf16(PAF(1),VFR(1),o[0],0,0,0), C0,8); \
    KRD(GL,1); GAPB(o[1]=__builtin_amdgcn_mfma_f32_32x32x16_bf16(PAF(1),VFR(5),o[1],0,0,0), C0,12); \
    KRD(GL,2); GAPB(o[0]=__builtin_amdgcn_mfma_f32_32x32x16_bf16(PAF(2),VFR(2),o[0],0,0,0), C1,0); \
    KRD(GL,3); GAPB(o[1]=__builtin_amdgcn_mfma_f32_32x32x16_bf16(PAF(2),VFR(6),o[1],0,0,0), C1,4); \
    KRD(GL,4); GAPB(o[0]=__builtin_amdgcn_mfma_f32_32x32x16_bf16(PAF(3),VFR(3),o[0],0,0,0), C1,8); \
    KRD(GL,5); GAPB(o[1]=__builtin_amdgcn_mfma_f32_32x32x16_bf16(PAF(3),VFR(7),o[1],0,0,0), C1,12); \
    }while(0)
  int t=1;
  #undef CMASK
  #define CMASK(P0,P1,t) do{}while(0)
  for(;t+5<NT;t+=2){
    STEP(pB0,pB1,pA0,pA1,t,true,true,true);     WAIT_BAR(3); RESC(); ROT();
    STEP(pA0,pA1,pB0,pB1,t+1,true,true,true);   WAIT_BAR(3); RESC(); ROT();
  }
  #undef CMASK
  #define CMASK(P0,P1,t) do{int jb_=(t)-(NT-4); if(jb_>=0)cmask(P0,P1,jb_,qrel,hi);}while(0)
  #define ENDW(tt) do{ if((tt)+3<NT){WAIT_BAR(3);} else if((tt)+2<NT){WAIT_BAR(1);} else {WAIT_BAR(0);} }while(0)
  for(;t+1<NT;t+=2){
    STEP(pB0,pB1,pA0,pA1,t,(t+3<NT),(t+1<NT),(t+1<NT));       ENDW(t);   RESC(); ROT();
    STEP(pA0,pA1,pB0,pB1,t+1,(t+4<NT),(t+2<NT),(t+2<NT));     ENDW(t+1); RESC(); ROT();
  }
  STEP(pB0,pB1,pA0,pA1,NT-1,false,false,false); RESC();
  { float sacc=pB0[0]+pB0[1]; _Pragma("unroll") for(int r=2;r<16;++r)sacc+=pB0[r]; _Pragma("unroll") for(int r=0;r<16;++r)sacc+=pB1[r]; l_reg+=sacc;
    pw0=(u32x4){PKW(pB0,0),PKW(pB0,2),PKW(pB0,4),PKW(pB0,6)};pw1=(u32x4){PKW(pB0,8),PKW(pB0,10),PKW(pB0,12),PKW(pB0,14)};pw2=(u32x4){PKW(pB1,0),PKW(pB1,2),PKW(pB1,4),PKW(pB1,6)};pw3=(u32x4){PKW(pB1,8),PKW(pB1,10),PKW(pB1,12),PKW(pB1,14)};
    SBAR(); pv(o,vb0+sl_cur,PAF(0),PAF(1),PAF(2),PAF(3)); }
  #undef PKW
  #undef PAF
  #undef VFR
  #undef PIN
  #undef MX3
  #undef GAPA
  #undef GAPB
  #undef EX
  #undef VRD
  #undef KRD
  #undef STEP
  #undef ENDW
  {auto rr=__builtin_amdgcn_permlane32_swap(__float_as_uint(l_reg),__float_as_uint(l_reg),false,false);l_reg=__uint_as_float(rr[0])+__uint_as_float(rr[1]);}
  if(hi==0)wsf[32+r32]=l_reg;asm volatile("s_waitcnt lgkmcnt(0)":::"memory");
  float rli[16];
  #pragma unroll
  for(int r=0;r<16;++r)rli[r]=__builtin_amdgcn_rcpf(wsf[32+crow(r,hi)]);
  bf16*Ow=O+((long)b*SEQ+q0+wid*QBLK)*OP+h*DVH;
  { bf16*stg=(bf16*)(shm+LDS_OST)+wid*2048;
    #pragma unroll
    for(int r=0;r<16;++r){const int orow=crow(r,hi);
      #pragma unroll
      for(int d0=0;d0<2;++d0)stg[orow*64+d0*32+r32]=__float2bfloat16(o[d0][r]*rli[r]);}
    asm volatile("s_waitcnt lgkmcnt(0)":::"memory");
    #pragma unroll
    for(int i=0;i<4;++i){const int row=i*8+(lane>>3),ch=lane&7; const u32x4 v=*(const u32x4*)(stg+row*64+ch*8); ATTN_STORE16(Ow+(long)row*OP+ch*8,v);} }
  asm volatile("s_waitcnt lgkmcnt(0)\n\ts_barrier":::"memory");
  #undef DMA_K
  #undef KOFF
  #undef DMA_V
  #undef CMASK
  #undef START
  #undef RESC
  #undef ROT
}
constexpr int ATTN_LDS_BYTES=LDS_BYTES;
struct AttnTensors { const bf16* Q; const bf16* K; const bf16* V; bf16* O; };
struct AttnUnit { int bh; int qb; };
struct StaticOrder {
  int vcu;
  __device__ __forceinline__ explicit StaticOrder(int grid,int block):vcu((block%8)*(grid/8)+block/8){}
  __device__ __forceinline__ bool next(int i,AttnUnit&u)const{ if(i>=4)return false; const int s=vcu&7; u.bh=vcu>>3; u.qb=(i==0)?s:(i==1)?15-s:(i==2)?16+s:31-s; return true; }
  __device__ __forceinline__ void a_ready(const AttnUnit&)const{}
  __device__ __forceinline__ void done(const AttnUnit&)const{}
};
template<class Sched,int THRL=8> __device__ __forceinline__ void attn_phase(char*lds,const AttnTensors&T,const Sched&S){
  AttnUnit u;
  for(int i=0;S.next(i,u);++i){ S.a_ready(u); attn_unit<THRL>(u.bh,u.qb,T.Q,T.K,T.V,T.O,lds); S.done(u); }
}
#undef SBAR
#undef WAIT_BAR
}

__global__ void __launch_bounds__(NTHREADS, 2) fwd(Args args) {
    extern __shared__ __attribute__((aligned(16))) char lds[];
    Frame F;
    F.lds = lds; F.tid = threadIdx.x; F.lane = F.tid & 63; F.wave = __builtin_amdgcn_readfirstlane(F.tid >> 6); F.G = gridDim.x; F.bid = blockIdx.x;
    unsigned char* ws = args.ws;
    F.ctl = (unsigned*)(ws + WS_CTL);
    F.x = (const float*)args.in[0]; F.p = (const float*)args.in[1]; F.pos = (const int*)args.in[2]; F.attn_g = (const float*)args.in[3]; F.w_in = (const float*)args.in[4];
    F.q_g = (const float*)args.in[5]; F.w_uq = (const float*)args.in[6]; F.kv_g = (const float*)args.in[7]; F.w_ukv = (const float*)args.in[8]; F.conv_w = (const float*)args.in[9];
    F.w_out = (const float*)args.in[10]; F.moe_g = (const float*)args.in[11]; F.w_gr = (const float*)args.in[12]; F.b_gr = (const float*)args.in[13]; F.w_er = (const float*)args.in[14];
    F.b_er = (const float*)args.in[15]; F.w_gate = (const float*)args.in[16]; F.w_up = (const float*)args.in[17]; F.w_down = (const float*)args.in[18]; F.ple_g = (const float*)args.in[19];
    F.w_pg = (const float*)args.in[20]; F.b_pg = (const float*)args.in[21]; F.w_pp = (const float*)args.in[22]; F.fin_g = (const float*)args.in[23];
    F.out = args.out;
    F.WinT = (bf16*)(ws + WS_WIN); F.WuqT = (bf16*)(ws + WS_WUQ); F.WukvT = (bf16*)(ws + WS_WUKV); F.WoutT = (bf16*)(ws + WS_WOUT); F.WpgT = (bf16*)(ws + WS_WPG); F.WppT = (bf16*)(ws + WS_WPP);
    F.WguT = (bf16*)(ws + WS_WGU); F.WdT = (bf16*)(ws + WS_WD); F.PB = (bf16*)(ws + WS_PB); F.RA = (bf16*)(ws + WS_A); F.Z = (bf16*)(ws + WS_B); F.HBUF = (bf16*)(ws + WS_B);
    F.PROJ = (bf16*)(ws + WS_B + OFF_PROJ); F.Q = (bf16*)(ws + WS_C); F.K = (bf16*)(ws + WS_C + OFF_K); F.V = (bf16*)(ws + WS_C + OFF_V); F.YBUF = (bf16*)(ws + WS_C);
    F.RWT = (float*)(ws + WS_RWT); F.ROPE = (float*)(ws + WS_ROPE); F.SSQ = (float*)(ws + WS_SSQ); F.AW = (float*)(ws + WS_AW); F.LIST = (int*)(ws + WS_LIST);

    for (int u = F.tid; u < (LDS_BYTES - LDS_MISC) / 4; u += NTHREADS) ((unsigned*)(lds + LDS_MISC))[u] = 0u;
    __syncthreads();
    volatile LAS unsigned* MISC = (volatile LAS unsigned*)(LAS char*)(lds + LDS_MISC);
    XcdBarrier bar = xcd_barrier_post(F.ctl + CW_BAR + args.ph_lo * XCD_BAR_WORDS, MISC + 8);
    const int lo = args.ph_lo, hi = args.ph_hi;
#define IN(k) (lo <= (k) && (k) < hi)
#define LDSP ((LAS unsigned char*)lds)
#define SEAM(k) do { if (IN(k) && IN((k) + 1)) xcd_barrier(bar); } while (0)

    if (IN(0)) { p0_prologue(F); } SEAM(0);
    if (IN(1)) {
        if constexpr (OPTP(1)) {
            mm::DenseSched S; S.init(F.RA, D, F.WinT, D, NTOK, ZC, F.G, F.bid);
            EpiZ E{F.Z, F.SSQ};
            mm::mm_phase<EpiZ, mm::DenseSched, true, false>(LDSP, D, D, D, S, E);
        } else {
        auto ez = [&](int row, int col, const float (&v)[8]) { *(u32x4*)(F.Z + (size_t)row * ZC + col) = pack8(v); };
        ngemm_dense(F, F.RA, D, F.WinT, D, NTOK, ZC, D, ez);
        xcd_barrier(bar);
        p1_ssq_from_z(F);
        }
    } SEAM(1);
    if (IN(2)) {
        if constexpr (OPTP(2)) {
            { mm::DenseSched S; S.init(F.Z + CQ0, ZC, F.WuqT, QLORA, NTOK, 768, F.G, F.bid);
              EpiQ E{F.SSQ, F.ROPE, F.Q};
              mm::mm_phase<EpiQ, mm::DenseSched, true, false>(LDSP, QLORA, ZC, QLORA, S, E); }
            { mm::DenseSched S; S.init(F.Z + CKV0, ZC, F.WukvT, KVLORA, NTOK, 1024, F.G, (F.bid + 128) % F.G);
              EpiKV E{F.SSQ, F.K, F.V};
              mm::mm_phase<EpiKV, mm::DenseSched, true, false>(LDSP, KVLORA, ZC, KVLORA, S, E); }
        } else {
        auto eq = [&](int row, int col, const float (&v)[8]) { epi_q(F, row, col, v); };
        ngemm_dense(F, F.Z + CQ0, ZC, F.WuqT, QLORA, NTOK, 768, QLORA, eq);
        auto ekv = [&](int row, int col, const float (&v)[8]) { epi_kv(F, row, col, v); };
        ngemm_dense(F, F.Z + CKV0, ZC, F.WukvT, KVLORA, NTOK, 1024, KVLORA, ekv);
        }
        p2_krope_conv(F);
    } SEAM(2);
    if (IN(3)) {
        if constexpr (OPTP(3)) {
            const attn96::AttnTensors AT{(const attn96::bf16*)F.Q, (const attn96::bf16*)F.K, (const attn96::bf16*)F.V, (attn96::bf16*)F.RA};
            const attn96::StaticOrder S(F.G, F.bid);
            attn96::attn_phase<attn96::StaticOrder>((char*)lds, AT, S);
        } else
        for (int it = F.bid; it < 256; it += F.G) { const int bh = it & 31, s = it >> 5;
            nattn_item(F, bh, s); nattn_item(F, bh, 15 - s); }
    } SEAM(3);
    if (IN(4)) {
        auto eh = [&](int row, int col, const float (&v)[8]) { const f32x4* xp = (const f32x4*)(F.x + (size_t)row * D + col); f32x4* op = (f32x4*)(F.out + (size_t)row * D + col);
            const f32x4 a = xp[0], b = xp[1]; op[0] = (f32x4){a.x + v[0], a.y + v[1], a.z + v[2], a.w + v[3]}; op[1] = (f32x4){b.x + v[4], b.y + v[5], b.z + v[6], b.w + v[7]}; };
        if constexpr (OPTP(4)) {
            mm::DenseSched S; S.init(F.RA, D, F.WoutT, D, NTOK, D, F.G, F.bid);
            EpiH1 E{F.x, F.out};
            mm::mm_phase<EpiH1, mm::DenseSched, true, false>(LDSP, D, D, D, S, E);
        } else
        ngemm_dense(F, F.RA, D, F.WoutT, D, NTOK, D, D, eh);
    } SEAM(4);
    if (IN(5)) { p5_route(F); } SEAM(5);
    if (IN(6)) {
        int* tb = (int*)(lds + LDS_MISC + 1024); int* cnts = tb + 40;
        moe_tile_table(F, tb, cnts);
        if constexpr (OPTP(6)) {
            MoeSched S{(const char*)F.RA, (const char*)F.WguT, F.LIST, (const LAS int*)(LDSP + LDS_MISC + 1024), (const LAS int*)(LDSP + LDS_MISC + 1024 + 160), D, D, 4, F.G, F.bid, (size_t)1024 * 1024 * 2, true};
            EpiGate E{F.HBUF};
            mm::mm_phase<EpiGate, MoeSched, true, true>(LDSP, D, D, D, S, E);
        } else {
        const int nrt = tb[NEXP], nit = nrt * 2 * 8;
        for (int it = F.bid; it < nit; it += F.G) { const int ct = it & 7, hf = (it >> 3) & 1, R = it >> 4;
            int e = 0; while (tb[e + 1] <= R) ++e;
            const int pos0 = (R - tb[e]) * 256 + hf * 128, cnt = cnts[e];
            bf16* hb = F.HBUF + ((size_t)R * 256 + hf * 128) * FF + ct * 64;
            auto epi = [&](int r, int c, const float (&g)[8], const float (&u)[8]) { float o[8];
#pragma unroll
                for (int j = 0; j < 8; ++j) o[j] = g[j] / (1.f + __expf(-g[j])) * u[j];
                *(u32x4*)(hb + (size_t)r * FF + c) = pack8(o); };
            const int j0 = ct * 64; const bf16* Bg = F.WguT + (size_t)e * 1024 * 1024 + (size_t)(256 * (j0 >> 7) + (j0 & 127)) * D;
            ngemm_tile<true>(F.lds, F.RA, D, F.LIST + e * LISTCAP + pos0, cnt - pos0, Bg, Bg + (size_t)128 * D, D, D, epi); }
        }
    } SEAM(6);
    if (IN(7)) {
        int* tb = (int*)(lds + LDS_MISC + 1024); int* cnts = tb + 40;
        moe_tile_table(F, tb, cnts);
        if constexpr (OPTP(7)) {
            MoeSched S{(const char*)F.HBUF, (const char*)F.WdT, F.LIST, (const LAS int*)(LDSP + LDS_MISC + 1024), (const LAS int*)(LDSP + LDS_MISC + 1024 + 160), FF, FF, 4, F.G, F.bid, (size_t)1024 * 512 * 2, false};
            EpiDown E{F.YBUF, F.AW, F.LIST, (const LAS int*)(LDSP + LDS_MISC + 1024 + 160)};
            mm::mm_phase<EpiDown, MoeSched, true, false>(LDSP, FF, FF, FF, S, E);
        } else {
        const int nrt = tb[NEXP], nit = nrt * 2 * 16;
        for (int it = F.bid; it < nit; it += F.G) { const int ct = it & 15, hf = (it >> 4) & 1, R = it >> 5;
            int e = 0; while (tb[e + 1] <= R) ++e;
            const int pos0 = (R - tb[e]) * 256 + hf * 128, cnt = cnts[e];
            const int* lst = F.LIST + e * LISTCAP + pos0;
            auto epi = [&](int r, int c, const float (&v)[8], const float (&v2)[8]) { if (pos0 + r < cnt) { const int a = lst[r]; const float w = F.AW[a]; float o[8];
#pragma unroll
                for (int j = 0; j < 8; ++j) o[j] = v[j] * w;
                *(u32x4*)(F.YBUF + (size_t)a * D + ct * 64 + c) = pack8(o); } };
            ngemm_tile<false>(F.lds, F.HBUF + ((size_t)R * 256 + hf * 128) * FF, FF, nullptr, 0, F.WdT + (size_t)e * 1024 * 512 + (size_t)ct * 64 * FF, nullptr, FF, FF, epi); }
        }
    } SEAM(7);
    if (IN(8)) {
        p8_combine(F);
        auto ep = [&](int row, int col, const float (&v)[8]) { *(u32x4*)(F.PROJ + (size_t)row * D + col) = pack8(v); };
        if constexpr (OPTP(8)) {
            mm::DenseSched S; S.init(F.PB, PLE, F.WppT, PLE, NTOK, D, F.G, F.bid);
            EpiBf E{F.PROJ, D};
            mm::mm_phase<EpiBf, mm::DenseSched, true, false>(LDSP, PLE, PLE, PLE, S, E);
        } else
        ngemm_dense(F, F.PB, PLE, F.WppT, PLE, NTOK, D, PLE, ep);
    } SEAM(8);
    if (IN(9)) {
        auto eg = [&](int row, int col, const float (&v)[8]) { f32x4* op = (f32x4*)(F.out + (size_t)row * D + col); float pr[8]; unpack8(*(const u32x4*)(F.PROJ + (size_t)row * D + col), pr);
            f32x4 a = op[0], b = op[1]; float o[8] = {a.x, a.y, a.z, a.w, b.x, b.y, b.z, b.w};
#pragma unroll
            for (int j = 0; j < 8; ++j) o[j] += pr[j] / (1.f + __expf(-(v[j] + F.b_pg[col + j])));
            op[0] = (f32x4){o[0], o[1], o[2], o[3]}; op[1] = (f32x4){o[4], o[5], o[6], o[7]}; };
        if constexpr (OPTP(9)) {
            mm::DenseSched S; S.init(F.RA, D, F.WpgT, D, NTOK, D, F.G, F.bid);
            EpiPle E{F.out, F.PROJ, F.b_pg};
            mm::mm_phase<EpiPle, mm::DenseSched, true, false>(LDSP, D, D, D, S, E);
        } else
        ngemm_dense(F, F.RA, D, F.WpgT, D, NTOK, D, D, eg);
    } SEAM(9);
    if (IN(10)) { p10_final(F); }
#undef IN
#undef SEAM
}

extern "C" void kernel_launch(void* const* d_in, const int* in_sizes, int n_in, void* d_out, int out_size, void* d_ws, size_t ws_size, hipStream_t stream) {
    static int grid = 0;
    if (grid == 0) {
        if (n_in != 24 || out_size != NTOK * D || ws_size < WS_END) { fprintf(stderr, "kernel_launch: unexpected shapes (n_in %d out %d ws %zu)\n", n_in, out_size, ws_size); grid = -1; return; }
        int dev = 0, cus = 0, per_cu = 0;
        if (hipGetDevice(&dev) != hipSuccess || hipDeviceGetAttribute(&cus, hipDeviceAttributeMultiprocessorCount, dev) != hipSuccess) { grid = -1; return; }
        if (hipFuncSetAttribute((const void*)fwd, hipFuncAttributeMaxDynamicSharedMemorySize, LDS_BYTES) != hipSuccess) { fprintf(stderr, "kernel_launch: hipFuncSetAttribute failed\n"); grid = -1; return; }
        if (hipOccupancyMaxActiveBlocksPerMultiprocessor(&per_cu, (const void*)fwd, NTHREADS, LDS_BYTES) != hipSuccess || per_cu < 1) fprintf(stderr, "kernel_launch: occupancy query says %d\n", per_cu);
        (void)hipGetLastError();
        grid = cus;
    }
    if (grid < 0) return;
    (void)hipMemsetAsync((char*)d_ws + WS_CTL, 0, CTL_ZERO_BYTES, stream);
    Args a{};
    for (int i = 0; i < 24; ++i) a.in[i] = d_in[i];
    a.out = (float*)d_out; a.ws = (unsigned char*)d_ws;
#ifndef MK_SPLIT
    a.ph_lo = 0; a.ph_hi = 11;
    hipLaunchKernelGGL(fwd, dim3(grid), dim3(NTHREADS), LDS_BYTES, stream, a);
#else
    for (int k = 0; k < 11; ++k) { a.ph_lo = k; a.ph_hi = k + 1; hipLaunchKernelGGL(fwd, dim3(grid), dim3(NTHREADS), LDS_BYTES, stream, a); }
#endif
}
```
